# Optimizing an MI355X kernel written in HIP

```python
import math
import jax, jax.numpy as jnp
from jax import lax
import numpy as np

D_MODEL = 1024
BATCH = 32
SEQ = 256
DEPTH = 2
DEC_BATCH = 4
DEC_SEQ = 4096
PAST_LEN = 256

GRID_W = 64
HEAD_DIM = 64
D_POOL = D_MODEL // 4
D_ATTN = D_MODEL // 2
D_DELTA = D_MODEL // 4
D_MIX = D_POOL + D_ATTN + D_DELTA
POOL_WINDOWS = (2, 4, 8, 16)
N_POOL_GROUPS = 4
POOL_GROUP_DIM = D_POOL // N_POOL_GROUPS
N_Q_HEADS = D_ATTN // HEAD_DIM
N_KV_HEADS = 2
Q_PER_KV = N_Q_HEADS // N_KV_HEADS
D_KV = N_KV_HEADS * HEAD_DIM
N_DELTA_HEADS = D_DELTA // HEAD_DIM
CONV_K = 4
CHUNK = 64
Q_BLOCK = 128
ROPE_THETA = 10000.0
EPS = 1e-6
IN_WIDTHS = (D_POOL, D_POOL, D_ATTN, D_KV, D_KV, D_ATTN, 3 * D_DELTA, 2 * N_DELTA_HEADS, 2 * N_DELTA_HEADS, D_DELTA)
D_IN = sum(IN_WIDTHS)

kernel_name = "hybrid_pool_gqa_deltanet_diffusion_step"


def rmsnorm(x, g):
    xf = x.astype(jnp.float32)
    y = xf * lax.rsqrt(jnp.mean(xf * xf, axis=-1, keepdims=True) + EPS)
    return (y * g.astype(jnp.float32)).astype(x.dtype)


def l2norm(x):
    xf = x.astype(jnp.float32)
    return xf * lax.rsqrt(jnp.sum(xf * xf, axis=-1, keepdims=True) + EPS)


def centred_mean_minus_self(u, w):
    L = u.shape[1]
    uf = u.astype(jnp.float32)
    cs = jnp.concatenate([jnp.zeros_like(uf[:, :1]), jnp.cumsum(uf, axis=1)], axis=1)
    t = jnp.arange(L)
    lo = jnp.clip(t - w // 2, 0, L)
    hi = jnp.clip(t - w // 2 + w, 0, L)
    cnt = (hi - lo).astype(jnp.float32)[None, :, None]
    return ((cs[:, hi] - cs[:, lo]) / cnt).astype(u.dtype) - u


def pool_mixer(u, pool_w, pool_scale):
    B, L, _ = u.shape
    ug = u.reshape(B, L, N_POOL_GROUPS, POOL_GROUP_DIM)
    pooled = jnp.stack([centred_mean_minus_self(ug[:, :, g], POOL_WINDOWS[g]) for g in range(N_POOL_GROUPS)], axis=2)
    out = jnp.einsum('blgc,gcd->blgd', pooled, pool_w).reshape(B, L, D_POOL)
    return out * pool_scale


def axial_rope(num_tokens):
    rows = num_tokens // GRID_W
    row = jnp.repeat(jnp.arange(rows, dtype=jnp.float32), GRID_W)
    col = (jnp.arange(rows * GRID_W) % GRID_W).astype(jnp.float32)
    axis_dim = HEAD_DIM // 2
    inv = ROPE_THETA ** (-jnp.arange(0, axis_dim, 2, dtype=jnp.float32) / axis_dim)
    ang = jnp.concatenate([row[:, None] * inv, col[:, None] * inv], axis=-1)
    return jnp.cos(ang), jnp.sin(ang)


def apply_rope(x, cos, sin):
    xf = x.astype(jnp.float32).reshape(x.shape[:-1] + (HEAD_DIM // 2, 2))
    x1, x2 = xf[..., 0], xf[..., 1]
    c = cos[None, :, None, :]
    s = sin[None, :, None, :]
    out = jnp.stack([x1 * c - x2 * s, x1 * s + x2 * c], axis=-1)
    return out.reshape(x.shape).astype(x.dtype)


def block_attention(q, k, v):
    B, Lq = q.shape[:2]
    nb = Lq // Q_BLOCK
    qb = q.reshape(B, nb, Q_BLOCK, N_KV_HEADS, Q_PER_KV, HEAD_DIM).transpose(1, 0, 2, 3, 4, 5)
    scale = HEAD_DIM ** -0.5

    def one_block(qblk):
        s = jnp.einsum('bqkgd,bskd->bkgqs', qblk, k, preferred_element_type=jnp.float32) * scale
        p = jax.nn.softmax(s, axis=-1).astype(v.dtype)
        return jnp.einsum('bkgqs,bskd->bqkgd', p, v)

    o = lax.map(one_block, qb)
    return o.transpose(1, 0, 2, 3, 4, 5).reshape(B, Lq, D_ATTN)


def centred_depthwise_conv(x, w):
    C = x.shape[-1]
    return lax.conv_general_dilated(
        x, w[:, None, :].astype(x.dtype), window_strides=(1,),
        padding=[(CONV_K // 2, CONV_K - 1 - CONV_K // 2)],
        dimension_numbers=('NWC', 'WIO', 'NWC'), feature_group_count=C)


def gated_delta_chunked(q, k, v, g, beta, s0):
    B, L, H, DK = q.shape
    DV = v.shape[-1]
    n = L // CHUNK
    f32 = jnp.float32

    def chunks(t):
        t = t.astype(f32).reshape((B, n, CHUNK, H) + t.shape[3:])
        return jnp.moveaxis(jnp.moveaxis(t, 1, 0), 3, 2)

    q = chunks(q) * DK ** -0.5
    k = chunks(k)
    v = chunks(v)
    g = chunks(g)
    beta = chunks(beta)
    gc = jnp.cumsum(g, axis=-1)
    idx = jnp.arange(CHUNK)
    incl = idx[:, None] >= idx[None, :]
    strict = idx[:, None] > idx[None, :]
    diff = gc[..., :, None] - gc[..., None, :]
    decay = jnp.where(incl, jnp.exp(jnp.where(incl, diff, 0.0)), 0.0)
    kb = k * beta[..., None]
    lower = jnp.where(strict, jnp.einsum('nbhid,nbhjd->nbhij', kb, k) * decay, 0.0)
    a = lower + jnp.eye(CHUNK, dtype=f32)
    u = lax.linalg.triangular_solve(a, v * beta[..., None], left_side=True, lower=True, unit_diagonal=True)
    w = lax.linalg.triangular_solve(a, kb * jnp.exp(gc)[..., None], left_side=True, lower=True, unit_diagonal=True)
    attn = jnp.einsum('nbhid,nbhjd->nbhij', q, k) * decay
    qg = q * jnp.exp(gc)[..., None]
    g_last = gc[..., -1]
    kdec = k * jnp.exp(g_last[..., None] - gc)[..., None]

    def step(S, inp):
        w_i, u_i, qg_i, a_i, kd_i, gl_i = inp
        v_new = u_i - jnp.einsum('bhck,bhkv->bhcv', w_i, S)
        o = jnp.einsum('bhck,bhkv->bhcv', qg_i, S) + jnp.einsum('bhij,bhjv->bhiv', a_i, v_new)
        S = S * jnp.exp(gl_i)[..., None, None] + jnp.einsum('bhck,bhcv->bhkv', kd_i, v_new)
        return S, o

    S, o = lax.scan(step, s0.astype(f32), (w, u, qg, attn, kdec, g_last))
    o = jnp.swapaxes(jnp.moveaxis(o, 0, 1), 2, 3).reshape(B, L, H, DV)
    return o, S


def trunk_layer(x, cond, w_mod, b_mod, norm_pre, norm_post, w_in, w_out, pool_w, pool_scale,
                q_norm, k_norm, conv_w, a_log, dt_bias, o_norm, ctx_k=None, ctx_v=None, ctx_state=None):
    B, L, _ = x.shape
    latent = ctx_k is not None
    mod = (jnp.dot(jax.nn.silu(cond), w_mod) + b_mod)[:, None, :]
    shift, scale, gate = jnp.split(mod, 3, axis=-1)
    h = rmsnorm(x, norm_pre) * (1 + scale) + shift
    z = jnp.einsum('bld,de->ble', h, w_in)
    points = np.cumsum(IN_WIDTHS)[:-1].tolist()
    u_pool, g_pool, q, k, v, g_attn, qkv_d, b_d, a_d, g_delta = jnp.split(z, points, axis=-1)

    o_pool = pool_mixer(u_pool, pool_w, pool_scale)

    q = rmsnorm(q.reshape(B, L, N_Q_HEADS, HEAD_DIM), q_norm)
    k = rmsnorm(k.reshape(B, L, N_KV_HEADS, HEAD_DIM), k_norm)
    v = v.reshape(B, L, N_KV_HEADS, HEAD_DIM)
    if latent:
        cos, sin = axial_rope(L)
        q_r = apply_rope(q, cos, sin)
        k_all = jnp.concatenate([apply_rope(k, cos, sin), ctx_k.astype(k.dtype)], axis=1)
        v_all = jnp.concatenate([v, ctx_v.astype(v.dtype)], axis=1)
    else:
        q_r, k_all, v_all = q, k, v
    o_attn = block_attention(q_r, k_all, v_all)

    qkv_d = jax.nn.silu(centred_depthwise_conv(qkv_d, conv_w))
    qd, kd, vd = jnp.split(qkv_d, 3, axis=-1)
    qd = l2norm(qd.reshape(B, L, N_DELTA_HEADS, HEAD_DIM))
    kd = l2norm(kd.reshape(B, L, N_DELTA_HEADS, HEAD_DIM))
    vd = vd.reshape(B, L, N_DELTA_HEADS, HEAD_DIM)
    beta = jax.nn.sigmoid(b_d.astype(jnp.float32)).reshape(B, L, 2, N_DELTA_HEADS)
    g = -jnp.exp(a_log.astype(jnp.float32)) * jax.nn.softplus(
        a_d.astype(jnp.float32).reshape(B, L, 2, N_DELTA_HEADS) + dt_bias.astype(jnp.float32))
    if latent:
        s0 = ctx_state
    else:
        s0 = jnp.zeros((B, 2, N_DELTA_HEADS, HEAD_DIM, HEAD_DIM), jnp.float32)
    o_f, s_f = gated_delta_chunked(qd, kd, vd, g[:, :, 0], beta[:, :, 0], s0[:, 0])
    o_b, s_b = gated_delta_chunked(jnp.flip(qd, 1), jnp.flip(kd, 1), jnp.flip(vd, 1),
                                   jnp.flip(g[:, :, 1], 1), jnp.flip(beta[:, :, 1], 1), s0[:, 1])
    o_delta = rmsnorm(o_f + jnp.flip(o_b, 1), o_norm).reshape(B, L, D_DELTA).astype(x.dtype)

    gates = jax.nn.silu(jnp.concatenate([g_pool, g_attn, g_delta], axis=-1))
    branches = jnp.concatenate([o_pool.astype(x.dtype), o_attn.astype(x.dtype), o_delta], axis=-1)
    y = jnp.einsum('ble,ed->bld', gates * branches, w_out)
    x = x + gate * rmsnorm(y, norm_post)
    if latent:
        return x
    return x, k, v, jnp.stack([s_f, s_b], axis=1).astype(x.dtype)


def setup_inputs(seed: int = 0) -> dict:
    key = jax.random.key(seed)
    ks = jax.random.split(key, 24)
    f32 = jnp.float32

    def nrm(k, shape, s):
        return jax.random.normal(k, shape, f32) * s

    x_prompt = nrm(ks[0], (BATCH, SEQ, D_MODEL), 1.0)
    x_sample = nrm(ks[1], (DEC_BATCH, DEC_SEQ, D_MODEL), 1.0)
    cache_attn_k = nrm(ks[2], (DEC_BATCH, DEPTH, PAST_LEN, N_KV_HEADS, HEAD_DIM), 1.0)
    cache_attn_v = nrm(ks[3], (DEC_BATCH, DEPTH, PAST_LEN, N_KV_HEADS, HEAD_DIM), 1.0)
    state_delta = nrm(ks[4], (DEC_BATCH, DEPTH, 2, N_DELTA_HEADS, HEAD_DIM, HEAD_DIM), HEAD_DIM ** -0.5)
    c = nrm(ks[5], (DEC_BATCH, D_MODEL), 1.0)
    c_ctx = nrm(ks[6], (D_MODEL,), 1.0)
    w_mod = nrm(ks[7], (DEPTH, D_MODEL, 3 * D_MODEL), 0.5 * D_MODEL ** -0.5)
    b_mod = nrm(ks[8], (DEPTH, 3 * D_MODEL), 0.01)
    norm_pre = 1.0 + nrm(ks[9], (DEPTH, D_MODEL), 0.02)
    norm_post = 1.0 + nrm(ks[10], (DEPTH, D_MODEL), 0.02)
    w_in = nrm(ks[11], (DEPTH, D_MODEL, D_IN), D_MODEL ** -0.5)
    w_out = nrm(ks[12], (DEPTH, D_MIX, D_MODEL), D_MIX ** -0.5)
    pool_w = nrm(ks[13], (DEPTH, N_POOL_GROUPS, POOL_GROUP_DIM, POOL_GROUP_DIM), POOL_GROUP_DIM ** -0.5)
    pool_scale = 1.0 + nrm(ks[14], (DEPTH, D_POOL), 0.02)
    q_norm = 1.0 + nrm(ks[15], (DEPTH, HEAD_DIM), 0.02)
    k_norm = 1.0 + nrm(ks[16], (DEPTH, HEAD_DIM), 0.02)
    conv_w = nrm(ks[17], (DEPTH, CONV_K, 3 * D_DELTA), CONV_K ** -0.5)
    a_log = jnp.log(jax.random.uniform(ks[18], (DEPTH, 2, N_DELTA_HEADS), f32, 1.0, 16.0))
    dt = jnp.exp(jax.random.uniform(ks[19], (DEPTH, 2, N_DELTA_HEADS), f32, math.log(1e-3), math.log(1e-1)))
    dt_bias = dt + jnp.log(-jnp.expm1(-dt))
    o_norm = 1.0 + nrm(ks[20], (DEPTH, HEAD_DIM), 0.02)
    return {"x_prompt": x_prompt, "x_sample": x_sample, "cache_attn_k": cache_attn_k,
            "cache_attn_v": cache_attn_v, "state_delta": state_delta, "c": c, "c_ctx": c_ctx,
            "w_mod": w_mod, "b_mod": b_mod, "norm_pre": norm_pre, "norm_post": norm_post,
            "w_in": w_in, "w_out": w_out, "pool_w": pool_w, "pool_scale": pool_scale,
            "q_norm": q_norm, "k_norm": k_norm, "conv_w": conv_w, "a_log": a_log,
            "dt_bias": dt_bias, "o_norm": o_norm}


def reference(x_prompt, x_sample, cache_attn_k, cache_attn_v, state_delta, c, c_ctx,
              w_mod, b_mod, norm_pre, norm_post, w_in, w_out, pool_w, pool_scale,
              q_norm, k_norm, conv_w, a_log, dt_bias, o_norm):
    ctx_cond = c_ctx[None, :]
    hp = x_prompt
    hs = x_sample
    new_k, new_v, new_s = [], [], []
    for l in range(DEPTH):
        lw = (w_mod[l], b_mod[l], norm_pre[l], norm_post[l], w_in[l], w_out[l], pool_w[l], pool_scale[l],
              q_norm[l], k_norm[l], conv_w[l], a_log[l], dt_bias[l], o_norm[l])
        hp, k_l, v_l, s_l = trunk_layer(hp, ctx_cond, *lw)
        hs = trunk_layer(hs, c, *lw, ctx_k=cache_attn_k[:, l], ctx_v=cache_attn_v[:, l],
                         ctx_state=state_delta[:, l])
        new_k.append(k_l)
        new_v.append(v_l)
        new_s.append(s_l)
    new_attn_k = jnp.stack(new_k, axis=1)
    new_attn_v = jnp.stack(new_v, axis=1)
    new_state_delta = jnp.stack(new_s, axis=1)
    return (hp, hs, new_attn_k, new_attn_v, new_state_delta)
```

```cpp
#include <hip/hip_runtime.h>
#include <hip/hip_cooperative_groups.h>
#include <hip/hip_bf16.h>
#include <cstdio>
#include <cstdint>
#include <cmath>
namespace cg = cooperative_groups;
constexpr int NWAVES = 8;
constexpr int DMOD = 1024, NPR = 8192, NSM = 16384, NTOK = 24576, NIN = 3072;
constexpr float EPS = 1e-6f;
constexpr size_t MiB = 1u << 20;
constexpr size_t WS_CTL = 0, CTL_ZERO_BYTES = 64 * 1024;
constexpr size_t WS_WIN = 1 * MiB;
constexpr size_t WS_WOUT = 13 * MiB;
constexpr size_t WS_POOLW = 17 * MiB;
constexpr size_t WS_MOD = 17 * MiB + 128 * 1024;
constexpr size_t WS_ROPE = 17 * MiB + 256 * 1024;
constexpr size_t WS_BG = 18 * MiB;
constexpr size_t WS_SS = 18 * MiB + 1536 * 1024;
constexpr size_t WS_X2 = 21 * MiB;
constexpr size_t WS_Z = 69 * MiB;
constexpr size_t WS_R4 = 117 * MiB;
constexpr size_t WS_H = WS_R4, WS_DN = WS_R4;
constexpr size_t WS_Q = WS_R4 + 96 * MiB, WS_KP = WS_R4 + 120 * MiB, WS_VP = WS_R4 + 122 * MiB, WS_KS = WS_R4 + 124 * MiB, WS_VS = WS_R4 + 129 * MiB, WS_END = WS_R4 + 134 * MiB;
static_assert(WS_END <= 256 * MiB, "ws map");
constexpr int CW_BAR = 1024;
constexpr size_t OUT_Y = 0, OUT_K = 25165824, OUT_V = 27262976, OUT_S = 29360128;
constexpr int RING_BYTES = 152576;
constexpr int MISC_OFF = RING_BYTES, LDS_BYTES = RING_BYTES + 512;

namespace pg8 {
#define PG8_LAS __attribute__((address_space(3)))
typedef unsigned short bf16_t;
typedef short bf16x8 __attribute__((ext_vector_type(8)));
typedef float f32x4 __attribute__((ext_vector_type(4)));
typedef unsigned u32x4 __attribute__((ext_vector_type(4)));
constexpr int BM = 256, BK = 64, HALF = 128, HTB = HALF * BK * 2  , STAGE_BYTES = 8 * HTB, NXCD = 8, WGM = 8;

__host__ __device__ __forceinline__ int lds_byte(int r, int c) { const int st = (r >> 4) * 2 + (c >> 5), rr = r & 15, cc = c & 31, ob = rr * 64 + cc * 2; return st * 1024 + (ob ^ (((ob >> 9) & 1) << 5)); }
__host__ __device__ __forceinline__ void stage_rc(int b, int& R, int& C) { const int st = b / 1024, sb = b % 1024, swz = sb ^ (((sb >> 9) & 1) << 5); R = (st >> 1) * 16 + swz / 64; C = (st & 1) * 32 + (swz % 64) / 2; }
__host__ __device__ __forceinline__ int perm32(int rho) { const int n = rho >> 4, i = rho & 15; return 8 * (i >> 2) + 4 * n + (i & 3); }

struct Unit { int pm, pn; };
struct Gemm { const bf16_t* A; const bf16_t* Bt; int M, N, K; };

struct StaticOrder {
    int nM, nN, nwg, G, c;
    __host__ __device__ void init(int M, int N, int G_, int c_) { nM = M / BM; nN = N / BM; nwg = nM * nN; G = G_; c = c_; }
    __host__ __device__ bool next(int i, Unit& u) const {
        const long L = (long)i * G + c; if (L >= nwg) return false;
        int wgid = (int)L; { const int q = nwg / NXCD, r = nwg % NXCD, xcd = wgid % NXCD, off = wgid / NXCD; wgid = (xcd < r ? xcd * (q + 1) : r * (q + 1) + (xcd - r) * q) + off; }
        const int nig = WGM * nN, gid = wgid / nig, fm = gid * WGM, gsz = (nM - fm) < WGM ? (nM - fm) : WGM;
        u.pm = fm + ((wgid % nig) % gsz); u.pn = (wgid % nig) / gsz; return true;
    }
    __device__ __forceinline__ void a_ready(const Unit&) const {}
    __device__ __forceinline__ void done(const Unit&) const {}
};

struct PaOrder {
    int x, j, r0, nr;
    __device__ __forceinline__ bool next(int i, Unit& u) const {
        if (i >= nr) return false;
        const int p = (r0 + i) * 32 + j, ci = p / 12; u.pm = 12 * x + (p - 12 * ci); u.pn = ci < 5 ? ci + 2 : (ci < 7 ? ci - 5 : ci); return true; }
    __device__ __forceinline__ void a_ready(const Unit&) const {}
    __device__ __forceinline__ void done(const Unit&) const {}
};
struct OneSched {
    int pm, pn;
    __device__ __forceinline__ bool next(int i, Unit& u) const { if (i > 0) return false; u.pm = pm; u.pn = pn; return true; }
    __device__ __forceinline__ void a_ready(const Unit&) const {}
    __device__ __forceinline__ void done(const Unit&) const {}
};

__device__ __forceinline__ unsigned cvt_pk_bf16(float lo, float hi) { unsigned r; asm volatile("v_cvt_pk_bf16_f32 %0, %1, %2" : "=v"(r) : "v"(lo), "v"(hi)); return r; }
typedef float f32x2 __attribute__((ext_vector_type(2)));
__device__ __forceinline__ float silu_f(float x) { return x * __builtin_amdgcn_rcpf(1.0f + __builtin_amdgcn_exp2f(-1.4426950408889634f * x)); }
__device__ __forceinline__ float softplus_f(float x) { return fmaxf(x, 0.f) + log1pf(__expf(-fabsf(x))); }
__device__ __forceinline__ u32x4 pack8(const float (&v)[8]) { u32x4 w; w.x = cvt_pk_bf16(v[0], v[1]); w.y = cvt_pk_bf16(v[2], v[3]); w.z = cvt_pk_bf16(v[4], v[5]); w.w = cvt_pk_bf16(v[6], v[7]); return w; }
struct EpiIn {
    static constexpr bool PERM = true, AFTER_DRAIN = false;
    unsigned char* ws; float* outK; float* outV;
    const PG8_LAS float* tab;
    int nostore;
    __device__ __forceinline__ void operator()(const f32x4 (&acc)[2][2][4][2], const Unit& u, int wr, int wc, int fr_in, int fq_in) const {
        int fr = fr_in, fq = fq_in; asm volatile("" : "+v"(fr), "+v"(fq));
        const int pn = u.pn, pm = u.pm;
        const int rowb = pm * BM + wr * 64 + fr;
        if (pn == 0 || pn == 1 || (pn >= 5 && pn != 11)) {
            bf16_t* dst; int colb; bool act;
            if (pn == 0) { dst = (bf16_t*)(ws + WS_Z); colb = 0; act = false; }
            else if (pn >= 7 && pn <= 9) { dst = (bf16_t*)(ws + WS_Z); colb = 256 + (pn - 7) * 256; act = false; }
            else if (pn == 1) { dst = (bf16_t*)(ws + WS_X2); colb = 0; act = true; }
            else if (pn == 10) { dst = (bf16_t*)(ws + WS_X2); colb = 768; act = true; }
            else { dst = (bf16_t*)(ws + WS_X2); colb = 256 + (pn - 5) * 256; act = true; }
            colb += 64 * wc + 8 * fq;
#pragma unroll
            for (int ai = 0; ai < 2; ++ai)
#pragma unroll
                for (int m = 0; m < 4; ++m) { bf16_t* rowp = dst + (size_t)(rowb + ai * HALF + m * 16) * 1024 + colb;
#pragma unroll
                    for (int bj = 0; bj < 2; ++bj) { float v[8];
#pragma unroll
                        for (int e = 0; e < 8; ++e) { const float x = acc[ai][bj][m][e >> 2][e & 3]; v[e] = act ? silu_f(x) : x; }
                        if (!nostore) { *(u32x4*)(rowp + bj * 32) = pack8(v); } } }
        } else if (pn == 11) {
            if (wc == 0 && fq < 2) {
                float* BG = (float*)(ws + WS_BG);
                f32x4 na[2], db[2];
#pragma unroll
                for (int n = 0; n < 2; ++n) { const f32x4 a = *(const PG8_LAS f32x4*)(tab + 2176 + 4 * n); db[n] = *(const PG8_LAS f32x4*)(tab + 2184 + 4 * n);
#pragma unroll
                    for (int e = 0; e < 4; ++e) na[n][e] = -__builtin_amdgcn_exp2f(1.4426950408889634f * a[e]); }
#pragma unroll
                for (int ai = 0; ai < 2; ++ai)
#pragma unroll
                    for (int m = 0; m < 4; ++m) { const int row = rowb + ai * HALF + m * 16; float* bp = BG + (size_t)row * 16 + 8 * fq;
#pragma unroll
                        for (int n = 0; n < 2; ++n) { const f32x4 v = acc[ai][0][m][n]; f32x4 o;
#pragma unroll
                            for (int e = 0; e < 4; ++e) {
                                const float sg = __builtin_amdgcn_rcpf(1.0f + __builtin_amdgcn_exp2f(-1.4426950408889634f * v[e]));
                                const float x = v[e] + db[n][e];
                                const float sp = fmaxf(x, 0.f) + 0.6931471805599453f * __builtin_amdgcn_logf(1.0f + __builtin_amdgcn_exp2f(-1.4426950408889634f * fabsf(x)));
                                o[e] = fq == 0 ? sg : na[n][e] * sp; }
                            if (!nostore) { *(f32x4*)(bp + 4 * n) = o; } } }
            }
        } else {
            const bool isq = (pn != 4), isk = (pn == 4 && wc < 2), latent = (pm >= 32), nrm = isq || isk, roped = latent && nrm;
            const PG8_LAS float* nw = tab + (isq ? 2048 : 2112); const PG8_LAS float* rope = tab;
            const float osc = isq ? 0.125f * 1.4426950408889634f : 1.0f;
            const int kvh = wc & 1;
#pragma unroll
            for (int ai = 0; ai < 2; ++ai)
#pragma unroll
                for (int m = 0; m < 4; ++m) {
                    const int row = rowb + ai * HALF + m * 16;
                    float rinv = 1.0f;
                    if (nrm) { float ss = 0.f;
#pragma unroll
                        for (int bj = 0; bj < 2; ++bj)
#pragma unroll
                            for (int n = 0; n < 2; ++n) { const f32x4 x = acc[ai][bj][m][n]; ss += (x[0] * x[0] + x[1] * x[1]) + (x[2] * x[2] + x[3] * x[3]); }
                        ss += __shfl_xor(ss, 16); ss += __shfl_xor(ss, 32);
                        rinv = rsqrtf(ss * (1.0f / 64.0f) + 1e-6f) * osc; }
                    const int t = latent ? ((row - 8192) & 4095) : (row & 255);
#pragma unroll
                    for (int bj = 0; bj < 2; ++bj) {
                        float v[8];
#pragma unroll
                        for (int e = 0; e < 8; ++e) v[e] = acc[ai][bj][m][e >> 2][e & 3];
                        if (nrm) { const f32x4 g0 = *(const PG8_LAS f32x4*)(nw + 32 * bj + 8 * fq), g1 = *(const PG8_LAS f32x4*)(nw + 32 * bj + 8 * fq + 4);
#pragma unroll
                            for (int e = 0; e < 4; ++e) { v[e] = v[e] * rinv * g0[e]; v[4 + e] = v[4 + e] * rinv * g1[e]; } }
                        if (roped) { const int pos = bj ? (t & 63) : (t >> 6);
                            const f32x4 c4 = *(const PG8_LAS f32x4*)(rope + pos * 16 + 4 * fq), s4 = *(const PG8_LAS f32x4*)(rope + 1024 + pos * 16 + 4 * fq);
#pragma unroll
                            for (int p = 0; p < 4; ++p) { const float x1 = v[2 * p], x2 = v[2 * p + 1]; v[2 * p] = x1 * c4[p] - x2 * s4[p]; v[2 * p + 1] = x1 * s4[p] + x2 * c4[p]; } }
                        if (isq) {
                            if (!nostore) { *(u32x4*)((bf16_t*)(ws + WS_Q) + (size_t)row * 512 + ((pn - 2) * 4 + wc) * 64 + 8 * fq + bj * 32) = pack8(v); }
                        } else if (!latent) {
                            const int b = row >> 8;
                            float* op = (isk ? outK : outV) + (size_t)b * (2 * 256 * 128) + (size_t)t * 128 + kvh * 64 + 8 * fq + bj * 32;
                            if (!nostore) { *(f32x4*)op = (f32x4){v[0], v[1], v[2], v[3]}; *(f32x4*)(op + 4) = (f32x4){v[4], v[5], v[6], v[7]}; }
                            if (!nostore) { *(u32x4*)((bf16_t*)(ws + (isk ? WS_KP : WS_VP)) + (size_t)row * 128 + kvh * 64 + 8 * fq + bj * 32) = pack8(v); }
                        } else {
                            const int b = (row - 8192) >> 12;
                            if (!nostore) { *(u32x4*)((bf16_t*)(ws + (isk ? WS_KS : WS_VS)) + ((size_t)b * 4352 + t) * 128 + kvh * 64 + 8 * fq + bj * 32) = pack8(v); }
                        }
                    }
                }
        }
    }
};
struct EpiOut {
    static constexpr bool PERM = true, AFTER_DRAIN = false;
    bf16_t* Y; float* SS;
    __device__ __forceinline__ void operator()(const f32x4 (&acc)[2][2][4][2], const Unit& u, int wr, int wc, int fr_in, int fq_in) const {
        int fr = fr_in, fq = fq_in; asm volatile("" : "+v"(fr), "+v"(fq));
        const int rowb = u.pm * BM + wr * 64 + fr, colb = u.pn * BM + wc * 32 + 8 * fq;
#pragma unroll
        for (int ai = 0; ai < 2; ++ai)
#pragma unroll
            for (int m = 0; m < 4; ++m) { const int row = rowb + ai * HALF + m * 16; bf16_t* rowp = Y + (size_t)row * 1024 + colb; float ss = 0.f;
#pragma unroll
                for (int bj = 0; bj < 2; ++bj) { const f32x4 v0 = acc[ai][bj][m][0], v1 = acc[ai][bj][m][1];
                    ss += (v0[0] * v0[0] + v0[1] * v0[1]) + (v0[2] * v0[2] + v0[3] * v0[3]) + (v1[0] * v1[0] + v1[1] * v1[1]) + (v1[2] * v1[2] + v1[3] * v1[3]);
                    u32x4 w; w.x = cvt_pk_bf16(v0[0], v0[1]); w.y = cvt_pk_bf16(v0[2], v0[3]); w.z = cvt_pk_bf16(v1[0], v1[1]); w.w = cvt_pk_bf16(v1[2], v1[3]);
                    *(u32x4*)(rowp + bj * HALF) = w; }
                ss += __shfl_xor(ss, 16); ss += __shfl_xor(ss, 32);
                if (fq == 0) SS[(size_t)row * 16 + u.pn * 4 + wc] = ss; }
    }
};

struct EpiNull {
    static constexpr bool PERM = true, AFTER_DRAIN = false;
    float* sink;
    __device__ __forceinline__ void operator()(const f32x4 (&acc)[2][2][4][2], const Unit& u, int wr, int wc, int fr, int fq) const {
        float s = 0.f;
#pragma unroll
        for (int ai = 0; ai < 2; ++ai)
#pragma unroll
            for (int bj = 0; bj < 2; ++bj)
#pragma unroll
                for (int m = 0; m < 4; ++m)
#pragma unroll
                    for (int n = 0; n < 2; ++n) s += (acc[ai][bj][m][n][0] + acc[ai][bj][m][n][1]) + (acc[ai][bj][m][n][2] + acc[ai][bj][m][n][3]);
        if (s != s) sink[u.pm * 12 + u.pn] = s;
    }
};

template <class Epi, class Sched, bool ALIGN_EPI = false, bool SP2 = false>
__device__ __forceinline__ void gemm_phase(PG8_LAS unsigned char* lds, const Gemm g, const Sched& S, const Epi& E) {
    int tid_l = threadIdx.x; asm volatile("" : "+v"(tid_l));
    const int tid = tid_l, wid = __builtin_amdgcn_readfirstlane(tid >> 6), lane = tid & 63, wr = wid >> 2, wc = wid & 3, fr = lane & 15, fq = lane >> 4;
    const int K = g.K, nt = K / BK;
    unsigned voffA[2], voffB[2];
#pragma unroll
    for (int i = 0; i < 2; ++i) { int R, C; stage_rc(tid * 16 + i * 8192, R, C); const int Rb = Epi::PERM ? ((R & ~31) + perm32(R & 31)) : R;
        voffA[i] = (unsigned)(R * K + C) * 2u; voffB[i] = (unsigned)(Rb * K + C) * 2u; }
    const size_t kstep = (size_t)(BK * 2);
    const size_t hstep = (size_t)HALF * K * 2;
    const size_t tstep = 2 * hstep;
    const unsigned ldsw = (unsigned)wid * 1024u;
    const int aoff = lds_byte(wr * 64 + fr, fq * 8), boff = lds_byte(wc * 32 + fr, fq * 8);
#define PG8_SA(b, h) (((b) * 2 + (h)) * HTB)
#define PG8_SB(b, h) ((4 + (b) * 2 + (h)) * HTB)
#define PG8_STAGE(bufoff, gbase, voff) do { _Pragma("unroll") for (int _i = 0; _i < 2; ++_i) \
        __builtin_amdgcn_global_load_lds((const unsigned*)((const char*)(gbase) + (voff)[_i]), (PG8_LAS unsigned*)(lds + (bufoff) + ldsw + _i * 8192), 16, 0, 0); } while (0)
#define PG8_LDA(dst, b, h) do { _Pragma("unroll") for (int m = 0; m < 4; ++m) _Pragma("unroll") for (int k = 0; k < 2; ++k) dst[m][k] = *(const PG8_LAS bf16x8*)(lds + PG8_SA(b, h) + aoff + m * 2048 + k * 1024); } while (0)
#define PG8_LDB(dst, b, h) do { _Pragma("unroll") for (int n = 0; n < 2; ++n) _Pragma("unroll") for (int k = 0; k < 2; ++k) dst[n][k] = *(const PG8_LAS bf16x8*)(lds + PG8_SB(b, h) + boff + n * 2048 + k * 1024); } while (0)
#define PG8_MMA(ai, bj, At, Bt) do { __builtin_amdgcn_s_setprio(1); _Pragma("unroll") for (int m = 0; m < 4; ++m) _Pragma("unroll") for (int n = 0; n < 2; ++n) _Pragma("unroll") for (int k = 0; k < 2; ++k) \
        acc[ai][bj][m][n] = __builtin_amdgcn_mfma_f32_16x16x32_bf16(Bt[n][k], At[m][k], acc[ai][bj][m][n], 0, 0, 0); __builtin_amdgcn_s_setprio(0); } while (0)
#define PG8_WAIT_V(n) asm volatile("s_waitcnt vmcnt(" #n ")" ::: "memory")
#define PG8_WAIT_L(n) asm volatile("s_waitcnt lgkmcnt(" #n ")" ::: "memory")
#define PG8_BAR __builtin_amdgcn_s_barrier()
#define PG8_SCHED __builtin_amdgcn_sched_barrier(0)
    Unit cur, nxt; int ui = 0;
    if (!S.next(0, cur)) return;
    f32x4 acc[2][2][4][2];
#pragma unroll
    for (int a = 0; a < 2; ++a)
#pragma unroll
        for (int b = 0; b < 2; ++b)
#pragma unroll
            for (int m = 0; m < 4; ++m)
#pragma unroll
                for (int n = 0; n < 2; ++n) acc[a][b][m][n] = (f32x4){0.f, 0.f, 0.f, 0.f};
    bf16x8 At[4][2], B0[2][2], B1[2][2];
    const char* cA = (const char*)g.A + (size_t)cur.pm * tstep; const char* cB = (const char*)g.Bt + (size_t)cur.pn * tstep;
    S.a_ready(cur);
    if constexpr (SP2) {
        PG8_STAGE(PG8_SB(0, 0), cB, voffB); PG8_STAGE(PG8_SB(0, 1), cB + hstep, voffB); PG8_STAGE(PG8_SA(0, 0), cA, voffA); PG8_STAGE(PG8_SA(0, 1), cA + hstep, voffA);
        if (wr == 1) PG8_BAR;
        PG8_WAIT_V(2); PG8_BAR;
        PG8_STAGE(PG8_SB(1, 0), cB + kstep, voffB); PG8_STAGE(PG8_SA(1, 0), cA + kstep, voffA); PG8_STAGE(PG8_SB(1, 1), cB + hstep + kstep, voffB);
        PG8_WAIT_V(6); PG8_BAR;
    } else {
        PG8_STAGE(PG8_SB(0, 0), cB, voffB); PG8_STAGE(PG8_SA(0, 0), cA, voffA); PG8_STAGE(PG8_SB(0, 1), cB + hstep, voffB); PG8_STAGE(PG8_SA(0, 1), cA + hstep, voffA);
        if (wr == 1) PG8_BAR;
        PG8_WAIT_V(4); PG8_BAR;
        PG8_STAGE(PG8_SB(1, 0), cB + kstep, voffB); PG8_STAGE(PG8_SA(1, 0), cA + kstep, voffA); PG8_STAGE(PG8_SB(1, 1), cB + hstep + kstep, voffB);
        PG8_WAIT_V(6); PG8_BAR;
    }
    for (;;) {
        const bool has_next = S.next(ui + 1, nxt);
        const char* nA = has_next ? (const char*)g.A + (size_t)nxt.pm * tstep : cA; const char* nB = has_next ? (const char*)g.Bt + (size_t)nxt.pn * tstep : cB;
        for (int t = 0; t < nt; t += 2) {
            const bool last = (t == nt - 2);
            const char* a1 = cA + (size_t)(t + 1) * kstep;
            const char* a2 = last ? nA : cA + (size_t)(t + 2) * kstep; const char* b2 = last ? nB : cB + (size_t)(t + 2) * kstep;
            const char* a3 = a2 + kstep; const char* b3 = b2 + kstep;
            if (last && has_next) S.a_ready(nxt);
            if constexpr (SP2) {
            PG8_LDB(B0, 0, 0); PG8_LDB(B1, 0, 1); PG8_SCHED; PG8_LDA(At, 0, 0); PG8_STAGE(PG8_SA(1, 1), a1 + hstep, voffA);
            PG8_WAIT_V(8); PG8_WAIT_L(0); PG8_BAR; PG8_MMA(0, 0, At, B0); PG8_MMA(0, 1, At, B1); PG8_BAR; PG8_SCHED;
            PG8_LDA(At, 0, 1); PG8_STAGE(PG8_SB(0, 0), b2, voffB); PG8_STAGE(PG8_SB(0, 1), b2 + hstep, voffB); PG8_STAGE(PG8_SA(0, 0), a2, voffA);
            PG8_WAIT_V(8); PG8_WAIT_L(0); PG8_BAR; PG8_MMA(1, 0, At, B0); PG8_MMA(1, 1, At, B1); PG8_BAR; PG8_SCHED;
            PG8_LDB(B0, 1, 0); PG8_LDB(B1, 1, 1); PG8_SCHED; PG8_LDA(At, 1, 0); PG8_STAGE(PG8_SA(0, 1), a2 + hstep, voffA);
            PG8_WAIT_V(8); PG8_WAIT_L(0); PG8_BAR; PG8_MMA(0, 0, At, B0); PG8_MMA(0, 1, At, B1); PG8_BAR; PG8_SCHED;
            PG8_LDA(At, 1, 1); PG8_STAGE(PG8_SB(1, 0), b3, voffB); PG8_STAGE(PG8_SB(1, 1), b3 + hstep, voffB); PG8_STAGE(PG8_SA(1, 0), a3, voffA);
            PG8_WAIT_V(8); PG8_WAIT_L(0); PG8_BAR; PG8_MMA(1, 0, At, B0); PG8_MMA(1, 1, At, B1); PG8_BAR; PG8_SCHED;
            } else {
            PG8_LDB(B0, 0, 0); PG8_SCHED; PG8_LDA(At, 0, 0); PG8_STAGE(PG8_SA(1, 1), a1 + hstep, voffA);
            PG8_WAIT_L(8); PG8_BAR; PG8_WAIT_L(0); PG8_MMA(0, 0, At, B0); PG8_BAR; PG8_SCHED;
            PG8_LDB(B1, 0, 1); PG8_STAGE(PG8_SB(0, 0), b2, voffB);
            PG8_BAR; PG8_WAIT_L(0); PG8_MMA(0, 1, At, B1); PG8_BAR;
            PG8_LDA(At, 0, 1); PG8_STAGE(PG8_SA(0, 0), a2, voffA);
            PG8_BAR; PG8_WAIT_L(0); PG8_MMA(1, 0, At, B0); PG8_BAR; PG8_SCHED;
            PG8_STAGE(PG8_SB(0, 1), b2 + hstep, voffB);
            PG8_WAIT_V(6); PG8_BAR; PG8_MMA(1, 1, At, B1); PG8_BAR;
            PG8_LDB(B0, 1, 0); PG8_SCHED; PG8_LDA(At, 1, 0); PG8_STAGE(PG8_SA(0, 1), a2 + hstep, voffA);
            PG8_WAIT_L(8); PG8_BAR; PG8_WAIT_L(0); PG8_MMA(0, 0, At, B0); PG8_BAR; PG8_SCHED;
            PG8_LDB(B1, 1, 1); PG8_STAGE(PG8_SB(1, 0), b3, voffB);
            PG8_BAR; PG8_WAIT_L(0); PG8_MMA(0, 1, At, B1); PG8_BAR;
            PG8_LDA(At, 1, 1); PG8_STAGE(PG8_SA(1, 0), a3, voffA);
            PG8_BAR; PG8_WAIT_L(0); PG8_MMA(1, 0, At, B0); PG8_BAR; PG8_SCHED;
            PG8_STAGE(PG8_SB(1, 1), b3 + hstep, voffB);
            PG8_WAIT_V(6); PG8_BAR; PG8_MMA(1, 1, At, B1); PG8_BAR;
            }
        }
        if constexpr (ALIGN_EPI) { if (wr == 0) PG8_BAR; }
        if constexpr (!Epi::AFTER_DRAIN) { E(acc, cur, wr, wc, fr, fq); S.done(cur); }
        if (!has_next) break;
#pragma unroll
        for (int a = 0; a < 2; ++a)
#pragma unroll
            for (int b = 0; b < 2; ++b)
#pragma unroll
                for (int m = 0; m < 4; ++m)
#pragma unroll
                    for (int n = 0; n < 2; ++n) acc[a][b][m][n] = (f32x4){0.f, 0.f, 0.f, 0.f};
        cur = nxt; cA = nA; cB = nB; ++ui;
        if constexpr (ALIGN_EPI) { if (wr == 1) PG8_BAR; }
    }
    PG8_WAIT_V(0);
    if constexpr (!ALIGN_EPI) { if (wr == 0) PG8_BAR; }
    PG8_BAR;
    if constexpr (Epi::AFTER_DRAIN) { E.fused(acc, cur, wr, wc, fr, fq, lds, wid, lane); S.done(cur); }
#undef PG8_SA
#undef PG8_SB
#undef PG8_STAGE
#undef PG8_LDA
#undef PG8_LDB
#undef PG8_MMA
#undef PG8_WAIT_V
#undef PG8_WAIT_L
#undef PG8_BAR
#undef PG8_SCHED
}
}

namespace attn_body {
using bf16=__hip_bfloat16;
using bf16x8=__attribute__((ext_vector_type(8)))short;
using s16x4=__attribute__((ext_vector_type(4)))short;
using f32x16=__attribute__((ext_vector_type(16)))float;
using u32x4=__attribute__((ext_vector_type(4)))unsigned;
constexpr int D=64;
constexpr int NW=8,QBLK=32,QB=QBLK*NW,KVBLK=64;
constexpr int ATTN_UNIT_ROWS=QB;
__device__ __forceinline__ int crow(int r,int hi){return (r&3)+8*(r>>2)+4*hi;}
#define SBAR() __builtin_amdgcn_sched_barrier(0)
constexpr int NSLOT=3, SLOTB=8192;
constexpr int LDS_K=0, LDS_V=NSLOT*SLOTB, LDS_WS=2*NSLOT*SLOTB, LDS_OST=LDS_WS+NW*64*4, LDS_BYTES=LDS_OST+NW*4096;
constexpr float C2=0.125f*1.4426950408889634f;
__device__ __forceinline__ void glds16(const void*gsrc,unsigned lds_dst){unsigned keep;
  asm volatile("s_mov_b32 %0, m0\n\ts_mov_b32 m0, %2\n\ts_nop 0\n\tglobal_load_lds_dwordx4 %1, off\n\ts_mov_b32 m0, %0":"=&s"(keep):"v"(gsrc),"s"(lds_dst):"memory");}
__device__ __forceinline__ float max3f(float a,float b,float c){float r;asm("v_max3_f32 %0, %1, %2, %3":"=v"(r):"v"(a),"v"(b),"v"(c));return r;}
__device__ __forceinline__ float max2f(float a,float b){float r;asm("v_max_f32_e32 %0, %1, %2":"=v"(r):"v"(a),"v"(b));return r;}
__device__ __forceinline__ float fadd_s(float a,float b){float r;asm("v_add_f32_e32 %0, %1, %2":"=v"(r):"v"(a),"v"(b));return r;}
__device__ __forceinline__ float fsub_s(float a,float b){float r;asm("v_sub_f32_e32 %0, %1, %2":"=v"(r):"v"(a),"v"(b));return r;}
typedef float f32x2_t __attribute__((ext_vector_type(2))); typedef __bf16 bf16x2_t __attribute__((ext_vector_type(2)));
__device__ __forceinline__ unsigned cvtpk_s(float lo,float hi){f32x2_t v={lo,hi};bf16x2_t b=__builtin_convertvector(v,bf16x2_t);return __builtin_bit_cast(unsigned,b);}
#define WAIT_BAR(N) asm volatile("s_waitcnt vmcnt(" #N ") lgkmcnt(0)\n\ts_barrier":::"memory")

__device__ __forceinline__ void qkt(f32x16&p0,f32x16&p1,const char*Kslot,const bf16x8*qr,const f32x16&negm,int r32,int hi){
  const int kb0=r32*128+(((r32&7)^hi)<<4);
  #pragma unroll
  for(int d0=0;d0<4;++d0){
    const bf16x8 b0=*reinterpret_cast<const bf16x8*>(Kslot+(kb0^(d0<<5)));
    const bf16x8 b1=*reinterpret_cast<const bf16x8*>(Kslot+(kb0^(d0<<5))+4096);
    if(d0==0){p0=__builtin_amdgcn_mfma_f32_32x32x16_bf16(b0,qr[0],negm,0,0,0);p1=__builtin_amdgcn_mfma_f32_32x32x16_bf16(b1,qr[0],negm,0,0,0);}
    else{p0=__builtin_amdgcn_mfma_f32_32x32x16_bf16(b0,qr[d0],p0,0,0,0);p1=__builtin_amdgcn_mfma_f32_32x32x16_bf16(b1,qr[d0],p1,0,0,0);}}
}
typedef __attribute__((address_space(3))) const char* lds_cptr;
typedef short v4i16_t __attribute__((ext_vector_type(4)));
typedef __attribute__((address_space(3))) const bf16x8* lds_k8;
__device__ __forceinline__ void kload2(bf16x8*kf,lds_cptr kslot,unsigned koff,int j){ const lds_cptr p=kslot+(koff^(unsigned)(j<<5)); kf[2*j]=*(lds_k8)p; kf[2*j+1]=*(lds_k8)(p+4096); }
__device__ __forceinline__ void kload8(bf16x8*kf,lds_cptr kslot,unsigned koff){ kload2(kf,kslot,koff,0); kload2(kf,kslot,koff,1); kload2(kf,kslot,koff,2); kload2(kf,kslot,koff,3); }
__device__ __forceinline__ s16x4 vtr(lds_cptr p){ return __builtin_bit_cast(s16x4,__builtin_amdgcn_ds_read_tr16_b64_v4i16((__attribute__((address_space(3))) v4i16_t*)p)); }
__device__ __forceinline__ float rowmax(const f32x16&p0,const f32x16&p1){
  float a=max3f(p0[0],p0[1],p1[0]),b=max3f(p0[2],p0[3],p1[1]);a=max3f(a,p1[2],p1[3]);
  #pragma unroll
  for(int r=4;r<16;r+=4){a=max3f(a,p0[r],p0[r+1]);b=max3f(b,p0[r+2],p0[r+3]);a=max3f(a,p1[r],p1[r+1]);b=max3f(b,p1[r+2],p1[r+3]);}
  const float m=max2f(a,b);
  auto rr=__builtin_amdgcn_permlane32_swap(__float_as_uint(m),__float_as_uint(m),false,false);
  return max2f(__uint_as_float(rr[0]),__uint_as_float(rr[1]));
}
__device__ __forceinline__ void pv(f32x16*o,int vb,bf16x8 pa0,bf16x8 pa1,bf16x8 pa2,bf16x8 pa3){
  #pragma unroll
  for(int d0=0;d0<2;++d0){s16x4 lo[4],hi[4];
    #pragma unroll
    for(int ks=0;ks<4;++ks){
      asm volatile("ds_read_b64_tr_b16 %0,%1 offset:%c2":"=&v"(lo[ks]):"v"(vb),"i"(d0*4096+ks*1024):"memory");
      asm volatile("ds_read_b64_tr_b16 %0,%1 offset:%c2":"=&v"(hi[ks]):"v"(vb),"i"(d0*4096+ks*1024+512):"memory");}
    asm volatile("s_waitcnt lgkmcnt(0)":::"memory");SBAR();
    #define PK(k) (bf16x8){lo[k][0],lo[k][1],lo[k][2],lo[k][3],hi[k][0],hi[k][1],hi[k][2],hi[k][3]}
    o[d0]=__builtin_amdgcn_mfma_f32_32x32x16_bf16(pa0,PK(0),o[d0],0,0,0);
    o[d0]=__builtin_amdgcn_mfma_f32_32x32x16_bf16(pa1,PK(1),o[d0],0,0,0);
    o[d0]=__builtin_amdgcn_mfma_f32_32x32x16_bf16(pa2,PK(2),o[d0],0,0,0);
    o[d0]=__builtin_amdgcn_mfma_f32_32x32x16_bf16(pa3,PK(3),o[d0],0,0,0);
    #undef PK
  }
}

#ifndef ATTN_STORE16
#define ATTN_STORE16(p,v) (*(u32x4*)(p)=(v))
#endif
template<int THRL> __device__ __forceinline__ void attn_unit(const bf16*Qu,int QP,const bf16*__restrict__ Kh,const bf16*__restrict__ Vh,int KVP,bf16*Ou,int OP,int NT,char*shm,bool dry=false){
  int tid_l=threadIdx.x; asm volatile("":"+v"(tid_l)); const int tid=tid_l,lane=tid&63,r32=lane&31,hi=lane>>5; const int wid=__builtin_amdgcn_readfirstlane(tid>>6);
  const bf16*Qw=Qu+(long)(wid*QBLK)*QP;
  const unsigned lds0=(unsigned)(uintptr_t)shm;
  float*wsf=(float*)(shm+LDS_WS)+wid*64;
  const bf16*ksrc=Kh+(long)(8*wid+(lane>>3))*KVP+(((lane&7)^((lane>>3)&7))*8);
  const bf16*vsrc=Vh+(long)(16*(wid&3)+(lane>>2))*KVP+(wid>>2)*32+(lane&3)*8;
  const unsigned kdst=lds0+LDS_K+wid*1024, vdst=lds0+LDS_V+wid*1024;
  #define DMA_K(t,slot) glds16(ksrc+(long)(t)*KVBLK*KVP,(unsigned)__builtin_amdgcn_readfirstlane(kdst+(slot)))
  #define DMA_V(t,slot) glds16(vsrc+(long)(t)*KVBLK*KVP,(unsigned)__builtin_amdgcn_readfirstlane(vdst+(slot)))
  const int vb0=(int)(lds0+LDS_V)+((lane>>4)&1)*32+(lane&3)*8+(4*hi+((lane&15)>>2))*64;
  const char*Kbase=shm+LDS_K; bf16x8 kf[8];
  const lds_cptr shm3=(lds_cptr)shm; const lds_cptr kp0=shm3+LDS_K; const unsigned koff=(unsigned)(r32*128+(((r32&7)^hi)<<4)); const lds_cptr vp0=shm3+LDS_V+((lane>>4)&1)*32+(lane&3)*8+(4*hi+((lane&15)>>2))*64;
  DMA_K(0,0);DMA_V(0,0);DMA_K(1,SLOTB);
  bf16x8 qr[4];
  #pragma unroll
  for(int d0=0;d0<4;++d0)qr[d0]=*reinterpret_cast<const bf16x8*>(&Qw[(long)r32*QP+d0*16+hi*8]);
  float mhat=0.f,l_reg=0.f;f32x16 o[2];o[0]=f32x16{};o[1]=f32x16{};f32x16 negm=f32x16{};asm volatile("":"+v"(negm));
  #define CMASK(P0,P1,t) do{}while(0)
  bool resc=false;
  #define START(P0,P1) do{ const float rm=rowmax(P0,P1); resc=false; \
    { const float dl=rm; mhat=fadd_s(mhat,dl); \
      _Pragma("unroll") for(int r=0;r<16;++r){P0[r]=fsub_s(P0[r],dl);P1[r]=fsub_s(P1[r],dl);} \
      _Pragma("unroll") for(int r=0;r<16;++r)negm[r]=-mhat; asm volatile("":"+v"(negm)); } \
    _Pragma("unroll") for(int r=0;r<16;++r)P0[r]=__builtin_amdgcn_exp2f(P0[r]); }while(0)
  #define RESC() do{ if(resc){ asm volatile("s_waitcnt lgkmcnt(0)":::"memory"); \
      _Pragma("unroll") for(int d_=0;d_<2;++d_) _Pragma("unroll") for(int r=0;r<16;++r)o[d_][r]*=wsf[crow(r,hi)]; } }while(0)
  f32x16 pA0,pA1,pB0,pB1;
  int sl_prev=0,sl_cur=0,sl_next=SLOTB;
  #define ROT() do{sl_prev=sl_cur;sl_cur=sl_next;sl_next=(sl_next==(NSLOT-1)*SLOTB)?0:sl_next+SLOTB;}while(0)
  DMA_K(2,2*SLOTB);
  WAIT_BAR(3);
  qkt(pA0,pA1,Kbase,qr,negm,r32,hi);asm volatile("s_nop 15\n\ts_nop 7":"+v"(pA0),"+v"(pA1));CMASK(pA0,pA1,0);
  START(pA0,pA1);
  _Pragma("unroll") for(int r=0;r<16;++r)pA1[r]=__builtin_amdgcn_exp2f(pA1[r]);
  WAIT_BAR(0);
  DMA_K(3,0);DMA_V(1,SLOTB);
  ROT();
  kload8(kf,kp0+sl_cur,koff);
  WAIT_BAR(2);
  s16x4 vlo[8],vhi[8]; u32x4 pw0,pw1,pw2,pw3;
  #define PKW(P,B) cvtpk_s(P[B],P[B+1])
  #define PAF(k) __builtin_bit_cast(bf16x8,pw##k)
  #define VFR(i) (bf16x8){vlo[i][0],vlo[i][1],vlo[i][2],vlo[i][3],vhi[i][0],vhi[i][1],vhi[i][2],vhi[i][3]}
  #define PIN(x) asm volatile("":"+v"(x))
  #define MX3(a,b,c) __builtin_fmaxf(__builtin_fmaxf((a),(b)),(c))
  #define GAPA(MF,A0,A1,A2,A3,W0,W1,PW) do{ MF; sacc+=A0; sacc+=A1; sacc+=A2; sacc+=A3; PIN(sacc); W0; W1; PIN(PW); SBAR(); }while(0)
  #define EX(v) __builtin_amdgcn_exp2f(v)
  #define GAPB(MF,X,B) do{ MF; X[B]=EX(X[B]); X[B+1]=EX(X[B+1]); X[B+2]=EX(X[B+2]); X[B+3]=EX(X[B+3]); PIN(X); SBAR(); }while(0)
  #define VRD(i) do{ vlo[i]=vtr(vp_+(((i)>>2)*4096+((i)&3)*1024)); vhi[i]=vtr(vp_+(((i)>>2)*4096+((i)&3)*1024+512)); }while(0)
  #define KRD(G,j) do{ if(G){ kload2(kf,kp0+sl_next,koff,j); SBAR(); } }while(0)
  #define STEP(C0,C1,P0,P1,t,GK,GV,GL) do{ SBAR(); \
    const lds_cptr vp_=vp0+sl_prev; \
    VRD(0); SBAR(); float sacc=(P0[0]+P0[1]); \
    GAPA(C0=__builtin_amdgcn_mfma_f32_32x32x16_bf16(kf[0],qr[0],negm,0,0,0), P0[2],P0[3],P0[4],P0[5],     pw0[0]=PKW(P0,0), pw0[1]=PKW(P0,2), pw0); \
    VRD(4); SBAR(); GAPA(C1=__builtin_amdgcn_mfma_f32_32x32x16_bf16(kf[1],qr[0],negm,0,0,0), P0[6],P0[7],P0[8],P0[9],     pw0[2]=PKW(P0,4), pw0[3]=PKW(P0,6), pw0); \
    VRD(1); SBAR(); GAPA(C0=__builtin_amdgcn_mfma_f32_32x32x16_bf16(kf[2],qr[1],C0,0,0,0),   P0[10],P0[11],P0[12],P0[13], pw1[0]=PKW(P0,8), pw1[1]=PKW(P0,10), pw1); \
    VRD(5); SBAR(); GAPA(C1=__builtin_amdgcn_mfma_f32_32x32x16_bf16(kf[3],qr[1],C1,0,0,0),   P0[14],P0[15],P1[0],P1[1],   pw1[2]=PKW(P0,12),pw1[3]=PKW(P0,14), pw1); \
    VRD(2); SBAR(); GAPA(C0=__builtin_amdgcn_mfma_f32_32x32x16_bf16(kf[4],qr[2],C0,0,0,0),   P1[2],P1[3],P1[4],P1[5],     pw2[0]=PKW(P1,0), pw2[1]=PKW(P1,2), pw2); \
    VRD(6); SBAR(); GAPA(C1=__builtin_amdgcn_mfma_f32_32x32x16_bf16(kf[5],qr[2],C1,0,0,0),   P1[6],P1[7],P1[8],P1[9],     pw2[2]=PKW(P1,4), pw2[3]=PKW(P1,6), pw2); \
    VRD(3); SBAR(); GAPA(C0=__builtin_amdgcn_mfma_f32_32x32x16_bf16(kf[6],qr[3],C0,0,0,0),   P1[10],P1[11],P1[12],P1[13], pw3[0]=PKW(P1,8), pw3[1]=PKW(P1,10), pw3); \
    VRD(7); SBAR(); GAPA(C1=__builtin_amdgcn_mfma_f32_32x32x16_bf16(kf[7],qr[3],C1,0,0,0),   P1[14],P1[15],0.f,0.f,       pw3[2]=PKW(P1,12),pw3[3]=PKW(P1,14), pw3); \
    l_reg+=sacc; \
    if(GK){DMA_K((t)+3,sl_cur);} if(GV){DMA_V((t)+1,sl_next);} \
    CMASK(C0,C1,t); \
    { float a=MX3(C0[0],C0[1],C1[0]),b=MX3(C0[2],C0[3],C1[1]); a=MX3(a,C1[2],C1[3]); \
      _Pragma("unroll") for(int r=4;r<16;r+=4){a=MX3(a,C0[r],C0[r+1]);b=MX3(b,C0[r+2],C0[r+3]);a=MX3(a,C1[r],C1[r+1]);b=MX3(b,C1[r+2],C1[r+3]);} \
      float rm=__builtin_fmaxf(a,b); { auto rr=__builtin_amdgcn_permlane32_swap(__float_as_uint(rm),__float_as_uint(rm),false,false); rm=__builtin_fmaxf(__uint_as_float(rr[0]),__uint_as_float(rr[1])); } \
      resc=false; \
      if(__builtin_expect(__any(rm>(float)THRL),0)){ const float dl=__builtin_fmaxf(rm,0.f); mhat+=dl; \
        _Pragma("unroll") for(int r=0;r<16;++r){C0[r]-=dl;C1[r]-=dl;} \
        _Pragma("unroll") for(int r=0;r<16;++r)negm[r]=-mhat; asm volatile("":"+v"(negm)); \
        const float f=__builtin_amdgcn_exp2f(-dl); l_reg*=f; if(hi==0)wsf[r32]=f; resc=true; } } \
    SBAR(); \
    GAPB(o[0]=__builtin_amdgcn_mfma_f32_32x32x16_bf16(PAF(0),VFR(0),o[0],0,0,0), C0,0); \
    GAPB(o[1]=__builtin_amdgcn_mfma_f32_32x32x16_bf16(PAF(0),VFR(4),o[1],0,0,0), C0,4); \
    KRD(GL,0); GAPB(o[0]=__builtin_amdgcn_mfma_f32_32x32x16_bf16(PAF(1),VFR(1),o[0],0,0,0), C0,8); \
    KRD(GL,1); GAPB(o[1]=__builtin_amdgcn_mfma_f32_32x32x16_bf16(PAF(1),VFR(5),o[1],0,0,0), C0,12); \
    KRD(GL,2); GAPB(o[0]=__builtin_amdgcn_mfma_f32_32x32x16_bf16(PAF(2),VFR(2),o[0],0,0,0), C1,0); \
    KRD(GL,3); GAPB(o[1]=__builtin_amdgcn_mfma_f32_32x32x16_bf16(PAF(2),VFR(6),o[1],0,0,0), C1,4); \
    GAPB(o[0]=__builtin_amdgcn_mfma_f32_32x32x16_bf16(PAF(3),VFR(3),o[0],0,0,0), C1,8); \
    GAPB(o[1]=__builtin_amdgcn_mfma_f32_32x32x16_bf16(PAF(3),VFR(7),o[1],0,0,0), C1,12); \
    }while(0)
  int t=1;
  for(;t+5<NT;t+=2){
    STEP(pB0,pB1,pA0,pA1,t,true,true,true);     WAIT_BAR(2); RESC(); ROT();
    STEP(pA0,pA1,pB0,pB1,t+1,true,true,true);   WAIT_BAR(2); RESC(); ROT();
  }
  #define ENDW(tt) do{ if((tt)+3<NT){WAIT_BAR(2);} else if((tt)+2<NT){WAIT_BAR(1);} else {WAIT_BAR(0);} }while(0)
  for(;t+1<NT;t+=2){
    STEP(pB0,pB1,pA0,pA1,t,(t+3<NT),(t+1<NT),(t+1<NT));       ENDW(t);   RESC(); ROT();
    STEP(pA0,pA1,pB0,pB1,t+1,(t+4<NT),(t+2<NT),(t+2<NT));     ENDW(t+1); RESC(); ROT();
  }
  STEP(pB0,pB1,pA0,pA1,NT-1,false,false,false); RESC();
  { float sacc=pB0[0]+pB0[1]; _Pragma("unroll") for(int r=2;r<16;++r)sacc+=pB0[r]; _Pragma("unroll") for(int r=0;r<16;++r)sacc+=pB1[r]; l_reg+=sacc;
    pw0=(u32x4){PKW(pB0,0),PKW(pB0,2),PKW(pB0,4),PKW(pB0,6)};pw1=(u32x4){PKW(pB0,8),PKW(pB0,10),PKW(pB0,12),PKW(pB0,14)};pw2=(u32x4){PKW(pB1,0),PKW(pB1,2),PKW(pB1,4),PKW(pB1,6)};pw3=(u32x4){PKW(pB1,8),PKW(pB1,10),PKW(pB1,12),PKW(pB1,14)};
    SBAR(); pv(o,vb0+sl_cur,PAF(0),PAF(1),PAF(2),PAF(3)); }
  #undef PKW
  #undef PAF
  #undef VFR
  #undef PIN
  #undef MX3
  #undef GAPA
  #undef GAPB
  #undef EX
  #undef VRD
  #undef KRD
  #undef STEP
  #undef ENDW
  {auto rr=__builtin_amdgcn_permlane32_swap(__float_as_uint(l_reg),__float_as_uint(l_reg),false,false);l_reg=__uint_as_float(rr[0])+__uint_as_float(rr[1]);}
  if(hi==0)wsf[32+r32]=l_reg;asm volatile("s_waitcnt lgkmcnt(0)":::"memory");
  float rli[16];
  #pragma unroll
  for(int r=0;r<16;++r)rli[r]=__builtin_amdgcn_rcpf(wsf[32+crow(r,hi)]);
  bf16*Ow=Ou+(long)(wid*QBLK)*OP;
  { bf16*stg=(bf16*)(shm+LDS_OST)+wid*2048;
    #pragma unroll
    for(int r=0;r<16;++r){const int orow=crow(r,hi);
      #pragma unroll
      for(int d0=0;d0<2;++d0)stg[orow*64+d0*32+r32]=__float2bfloat16(o[d0][r]*rli[r]);}
    asm volatile("s_waitcnt lgkmcnt(0)":::"memory");
    #pragma unroll
    for(int i=0;i<4;++i){const int row=i*8+(lane>>3),ch=lane&7; const u32x4 v=*(const u32x4*)(stg+row*64+ch*8); const u32x4 g=*(const u32x4*)(Ow+(long)row*OP+ch*8); u32x4 w;
      #pragma unroll
      for(int e=0;e<4;++e){const float lo=__uint_as_float(v[e]<<16)*__uint_as_float(g[e]<<16),hh=__uint_as_float(v[e]&0xffff0000u)*__uint_as_float(g[e]&0xffff0000u); w[e]=cvtpk_s(lo,hh);}
      ATTN_STORE16(Ow+(long)row*OP+ch*8,dry?g:w);} }
  asm volatile("s_waitcnt lgkmcnt(0)\n\ts_barrier":::"memory");
  #undef DMA_K
  #undef DMA_V
  #undef CMASK
  #undef START
  #undef RESC
  #undef ROT
}
constexpr int ATTN_LDS_BYTES=LDS_BYTES;
#undef SBAR
#undef WAIT_BAR
}

#define GAS __attribute__((address_space(1)))
#define LAS __attribute__((address_space(3)))
typedef unsigned short bf16;
typedef unsigned v4u __attribute__((ext_vector_type(4)));
typedef unsigned v2u __attribute__((ext_vector_type(2)));
typedef float f32x4 __attribute__((ext_vector_type(4)));
typedef short bf16x8 __attribute__((ext_vector_type(8)));
typedef GAS unsigned gu32;
#define RLX_AGENT __ATOMIC_RELAXED, __HIP_MEMORY_SCOPE_AGENT
#define LDS_WAIT() asm volatile("s_waitcnt lgkmcnt(0)" ::: "memory")
typedef float f32x2_t __attribute__((ext_vector_type(2))); typedef __bf16 bf16x2_t __attribute__((ext_vector_type(2)));
__device__ __forceinline__ unsigned pk2(float lo, float hi) { f32x2_t v = {lo, hi}; return __builtin_bit_cast(unsigned, __builtin_convertvector(v, bf16x2_t)); }
__device__ __forceinline__ unsigned f2bf(float f) { return pk2(f, 0.f) & 0xffffu; }
__device__ __forceinline__ float bflo(unsigned u) { return __uint_as_float(u << 16); }
__device__ __forceinline__ float bfhi(unsigned u) { return __uint_as_float(u & 0xffff0000u); }
__device__ __forceinline__ float bf1(bf16 u) { return __uint_as_float((unsigned)u << 16); }

#define XB_TMO      128
#define XB_XCNT(j)  (256  + 64 * (j))
#define XB_XSUB(j)  (1280 + 64 * (j))
#define XB_XGEN(j)  (2304 + 64 * (j))
#define XB_TOP      3328
#define XB_TOPGEN   3392
#define XCD_BAR_WORDS 3456
#define XB_SPIN_CAP (1u << 20)
__device__ __forceinline__ unsigned xb_ld(unsigned* p)              { return __hip_atomic_load(p, __ATOMIC_RELAXED, __HIP_MEMORY_SCOPE_AGENT); }
__device__ __forceinline__ unsigned xb_add(unsigned* p, unsigned v) { return __hip_atomic_fetch_add(p, v, __ATOMIC_RELAXED, __HIP_MEMORY_SCOPE_AGENT); }
__device__ __forceinline__ unsigned xb_xcc_id() { return (unsigned)__builtin_amdgcn_s_getreg((3 << 11) | 20) & 0xFu; }
#define XB_SPIN(cond, bar) do { unsigned _sp = 0; while (cond) { __builtin_amdgcn_s_sleep(1); \
    if ((++_sp & 255u) == 0u) { if (xb_ld(&(bar)[XB_TMO])) break; if (_sp > XB_SPIN_CAP) { atomicAdd(&(bar)[XB_TMO], 1u); break; } } } } while (0)
struct XcdBarrier { unsigned* bar; unsigned x; volatile LAS unsigned* st; };
__device__ __forceinline__ XcdBarrier xcd_barrier_post(unsigned* bar, volatile LAS unsigned* st) {
    XcdBarrier b; b.bar = bar; b.x = xb_xcc_id(); b.st = st;
    if (threadIdx.x == 0) (void)xb_add(&bar[XB_XCNT(b.x)], 1u);
    return b;
}
__device__ __forceinline__ void xcd_barrier_complete(unsigned* bar, unsigned x, unsigned& nloc, unsigned& nx) {
    const unsigned G = gridDim.x * gridDim.y * gridDim.z;
    unsigned sum, cnt, mine, sp = 0u;
    for (;;) {
        sum = 0u; cnt = 0u; mine = 0u;
#pragma unroll
        for (unsigned j = 0; j < 16; ++j) { const unsigned c = xb_ld(&bar[XB_XCNT(j)]); sum += c; cnt += (c > 0u) ? 1u : 0u; mine = (j == x) ? c : mine; }
        if (sum == G) break;
        __builtin_amdgcn_s_sleep(1);
        if ((++sp & 255u) == 0u) { if (xb_ld(&bar[XB_TMO])) break; if (sp > XB_SPIN_CAP) { atomicAdd(&bar[XB_TMO], 1u); break; } }
    }
    nloc = mine > 0u ? mine : 1u; nx = cnt > 0u ? cnt : 1u;
}
__device__ __forceinline__ void xcd_barrier(const XcdBarrier& b) {
    asm volatile("s_waitcnt vmcnt(0)" ::: "memory");
    __syncthreads();
    if (threadIdx.x == 0) {
        unsigned* bar = b.bar; unsigned bx = b.x; asm volatile("" : "+s"(bx));
        __builtin_amdgcn_s_waitcnt(0);
        unsigned nloc = b.st[0], nx = b.st[1];
        if (nloc == 0u) { xcd_barrier_complete(bar, bx, nloc, nx); b.st[0] = nloc; b.st[1] = nx; }
        const unsigned old = xb_add(&bar[XB_XSUB(bx)], 1u);
        const unsigned gen = old / nloc;
        if (old + 1u == (gen + 1u) * nloc) {
            __builtin_amdgcn_fence(__ATOMIC_RELEASE, "agent");
            asm volatile("s_waitcnt vmcnt(0)" ::: "memory");
            const unsigned og = xb_add(&bar[XB_TOP], 1u);
            const unsigned tg = og / nx;
            if (og + 1u == (tg + 1u) * nx) xb_add(&bar[XB_TOPGEN], 1u);
            else XB_SPIN(xb_ld(&bar[XB_TOPGEN]) == tg, bar);
            __builtin_amdgcn_fence(__ATOMIC_ACQUIRE, "agent");
            xb_add(&bar[XB_XGEN(bx)], 1u);
            asm volatile("s_waitcnt vmcnt(0)" ::: "memory");
        } else {
            XB_SPIN(xb_ld(&bar[XB_XGEN(bx)]) == gen, bar);
            __builtin_amdgcn_fence(__ATOMIC_ACQUIRE, "agent");
            asm volatile("s_waitcnt vmcnt(0)" ::: "memory");
        }
    }
    __syncthreads();
}

#define XB_S_CNT(k, j) (4096 + 1024 * (k) + 64 * (j))
#define XB_S_TOP(k)    (4096 + 1024 * (k) + 992)
__device__ __forceinline__ void xcd_arrive(const XcdBarrier& b, int k) {
    asm volatile("s_waitcnt vmcnt(0)" ::: "memory");
    __syncthreads();
    if (threadIdx.x == 0) {
        unsigned* bar = b.bar; const unsigned nloc = b.st[0]; unsigned bx = b.x; asm volatile("" : "+s"(bx));
        const unsigned old = xb_add(&bar[XB_S_CNT(k, bx)], 1u);
        if (old + 1u == nloc) {
            __builtin_amdgcn_fence(__ATOMIC_RELEASE, "agent");
            asm volatile("s_waitcnt vmcnt(0)" ::: "memory");
            xb_add(&bar[XB_S_TOP(k)], 1u);
        }
    }
}
__device__ __forceinline__ void xcd_wait(const XcdBarrier& b, int k) {
    if (threadIdx.x == 0) {
        unsigned* bar = b.bar; const unsigned nx = b.st[1];
        XB_SPIN(xb_ld(&bar[XB_S_TOP(k)]) != nx, bar);
        __builtin_amdgcn_fence(__ATOMIC_ACQUIRE, "agent");
        asm volatile("s_waitcnt vmcnt(0)" ::: "memory");
    }
    __syncthreads();
}

struct Args { const float* in[21]; float* out; unsigned char* ws; };

__device__ __forceinline__ float wave_sum(float v) {
    v += __int_as_float(__builtin_amdgcn_update_dpp(0, __float_as_int(v), 0xB1, 0xF, 0xF, true));
    v += __int_as_float(__builtin_amdgcn_update_dpp(0, __float_as_int(v), 0x4E, 0xF, 0xF, true));
    v += __int_as_float(__builtin_amdgcn_update_dpp(0, __float_as_int(v), 0x141, 0xF, 0xF, true));
    v += __int_as_float(__builtin_amdgcn_update_dpp(0, __float_as_int(v), 0x140, 0xF, 0xF, true));
    const int b = __float_as_int(v);
    return (__int_as_float(__builtin_amdgcn_readlane(b, 0)) + __int_as_float(__builtin_amdgcn_readlane(b, 16))) + (__int_as_float(__builtin_amdgcn_readlane(b, 32)) + __int_as_float(__builtin_amdgcn_readlane(b, 48)));
}
__device__ __forceinline__ float fsilu(float x) { return x * __builtin_amdgcn_rcpf(1.0f + __builtin_amdgcn_exp2f(-1.4426950408889634f * x)); }
__device__ __forceinline__ f32x4 mfma16(bf16x8 a, bf16x8 b, f32x4 c) { return __builtin_amdgcn_mfma_f32_16x16x32_bf16(a, b, c, 0, 0, 0); }

__device__ __forceinline__ void* ldptr(volatile LAS unsigned* M, int w) {
    unsigned base = (unsigned)(uintptr_t)M; asm volatile("" : "+v"(base));
    volatile LAS unsigned* p = (volatile LAS unsigned*)(uintptr_t)base;
    const unsigned lo = __builtin_amdgcn_readfirstlane(p[w]), hi = __builtin_amdgcn_readfirstlane(p[w + 1]); return (void*)(GAS void*)(((unsigned long long)hi << 32) | (unsigned long long)lo); }
__device__ __forceinline__ void p0_transpose_item(const float* W, int Nsrc, int nsrc0, bf16* WT, int K, int drow0, LAS float* scr, int k0, int lane) {
    float x[32];
#pragma unroll
    for (int i = 0; i < 32; ++i) { const int kk = 2 * i + (lane >> 5); x[i] = W[(size_t)(k0 + kk) * Nsrc + nsrc0 + (lane & 31)]; }
#pragma unroll
    for (int i = 0; i < 32; ++i) { const int kk = 2 * i + (lane >> 5); scr[kk * 33 + (lane & 31)] = x[i]; }
    LDS_WAIT(); asm volatile("" ::: "memory");
    const int c = lane & 7;
#pragma unroll
    for (int j = 0; j < 4; ++j) { const int n = (lane >> 3) + 8 * j; const LAS float* s = scr + (8 * c) * 33 + n;
        v4u o; o.x = pk2(s[0 * 33], s[1 * 33]); o.y = pk2(s[2 * 33], s[3 * 33]); o.z = pk2(s[4 * 33], s[5 * 33]); o.w = pk2(s[6 * 33], s[7 * 33]);
        *(GAS v4u*)(WT + (size_t)(drow0 + n) * K + k0 + 8 * c) = o; }
    LDS_WAIT(); asm volatile("" ::: "memory");
}

#define INP(i) ((const float*)ldptr(MISC, 32 + 2 * (i)))
#define OUTP ((float*)ldptr(MISC, 32 + 42))
#define WSP ((unsigned char*)ldptr(MISC, 32 + 44))
template <int PD_R> __device__ __forceinline__ void pd_rows(volatile LAS unsigned* MISC, const int l, const int rbeg, const int rend, const int wrank, const int nwr, const int lane) {
    unsigned char* ws = WSP; float* out = OUTP; const float* x_prompt = INP(0); const float* x_sample = INP(1); const float* norm_pre = INP(9); const float* norm_post = INP(10);
    const float* modv = (const float*)(ws + WS_MOD); const float* SS = (const float*)(ws + WS_SS); const bf16* Yb = (const bf16*)(ws + WS_Z); bf16* Hb = (bf16*)(ws + WS_H);
    for (int row0 = rbeg + PD_R * wrank; row0 < rend; row0 += PD_R * nwr) {
        const int ci = row0 < NPR ? 0 : 1 + ((row0 - NPR) >> 12);
        const float* src = (l == 2) ? out + (size_t)row0 * DMOD : (row0 < NPR ? x_prompt + (size_t)row0 * DMOD : x_sample + (size_t)(row0 - NPR) * DMOD);
        f32x4 v[PD_R][4];
#pragma unroll
        for (int r = 0; r < PD_R; ++r)
#pragma unroll
            for (int j = 0; j < 4; ++j) v[r][j] = __builtin_nontemporal_load((const f32x4*)(src + (size_t)r * DMOD + 4 * lane + 256 * j));
        if (l > 0) {
            v2u yy[PD_R][4]; float ssp[PD_R];
#pragma unroll
            for (int r = 0; r < PD_R; ++r) { ssp[r] = lane < 16 ? SS[(size_t)(row0 + r) * 16 + lane] : 0.f;
#pragma unroll
                for (int j = 0; j < 4; ++j) yy[r][j] = __builtin_nontemporal_load((const v2u*)(Yb + (size_t)(row0 + r) * 1024 + 4 * lane + 256 * j)); }
            const float* gp = modv + (size_t)((l - 1) * 5 + ci) * 3072 + 2048; const float* np = norm_post + (l - 1) * 1024;
            asm volatile("" : "+s"(np));
            float rinv[PD_R];
#pragma unroll
            for (int r = 0; r < PD_R; ++r) rinv[r] = __int_as_float(__builtin_amdgcn_readfirstlane(__float_as_int(rsqrtf(wave_sum(ssp[r]) * (1.0f / 1024.0f) + EPS))));
#pragma unroll
            for (int j = 0; j < 4; ++j) { const int col = 4 * lane + 256 * j; const f32x4 g4 = *(const f32x4*)(gp + col), n4 = *(const f32x4*)(np + col);
#pragma unroll
                for (int r = 0; r < PD_R; ++r) { const v2u y2 = yy[r][j];
                    v[r][j][0] += g4[0] * (bflo(y2.x) * rinv[r] * n4[0]); v[r][j][1] += g4[1] * (bfhi(y2.x) * rinv[r] * n4[1]);
                    v[r][j][2] += g4[2] * (bflo(y2.y) * rinv[r] * n4[2]); v[r][j][3] += g4[3] * (bfhi(y2.y) * rinv[r] * n4[3]);
                    __builtin_nontemporal_store(v[r][j], (f32x4*)(out + (size_t)(row0 + r) * DMOD + col)); } }
        }
        if (l < 2) {
            float rinv2[PD_R];
#pragma unroll
            for (int r = 0; r < PD_R; ++r) { float s2 = 0.f;
#pragma unroll
                for (int j = 0; j < 4; ++j) s2 += (v[r][j][0] * v[r][j][0] + v[r][j][1] * v[r][j][1]) + (v[r][j][2] * v[r][j][2] + v[r][j][3] * v[r][j][3]);
                rinv2[r] = __int_as_float(__builtin_amdgcn_readfirstlane(__float_as_int(rsqrtf(wave_sum(s2) * (1.0f / 1024.0f) + EPS)))); }
            const float* mp = modv + (size_t)(l * 5 + ci) * 3072; const float* np = norm_pre + l * 1024;
            asm volatile("" : "+s"(np));
#pragma unroll
            for (int j = 0; j < 4; ++j) { const int col = 4 * lane + 256 * j;
                const f32x4 sh = *(const f32x4*)(mp + col), scl = *(const f32x4*)(mp + 1024 + col), n4 = *(const f32x4*)(np + col);
#pragma unroll
                for (int r = 0; r < PD_R; ++r) { f32x4 h;
#pragma unroll
                    for (int e = 0; e < 4; ++e) h[e] = v[r][j][e] * rinv2[r] * n4[e] * (1.0f + scl[e]) + sh[e];
                    v2u o; o.x = pk2(h[0], h[1]); o.y = pk2(h[2], h[3]);
                    *(v2u*)(Hb + (size_t)(row0 + r) * 1024 + col) = o; } }
        }
    }
}

__device__ __forceinline__ void ctx_rows(volatile LAS unsigned* MISC, const int l, const int gt, const int NGT) {
    unsigned char* ws = WSP; const float* cache_k = INP(2); const float* cache_v = INP(3); bf16* KSb = (bf16*)(ws + WS_KS); bf16* VSb = (bf16*)(ws + WS_VS);
    for (int idx = gt; idx < 2 * 32768; idx += NGT) { const int kv = idx >> 15, r = idx & 32767, b = r >> 13, j = (r >> 5) & 255, c4 = (r & 31) * 4;
        const float* sp = (kv ? cache_v : cache_k) + ((size_t)((b * 2 + l) * 256 + j)) * 128 + c4;
        const f32x4 x = *(const f32x4*)sp; v2u o; o.x = pk2(x[0], x[1]); o.y = pk2(x[2], x[3]);
        *(v2u*)((kv ? VSb : KSb) + ((size_t)b * 4352 + 4096 + j) * 128 + c4) = o; }
}

constexpr int DN_TS = 144;
constexpr int DN_TKN = 0, DN_TQN = 9216, DN_TKT = 18432, DN_TVN = 27648, DN_DIRB = 36864, DN_DIRSZ = 57600;
constexpr int DN_LF = 0, DN_WT = 17408, DN_WDT = 26624, DN_UT = 35840, DN_UDT = 45056, DN_SC = 54272, DN_TI = 55552;
static_assert(DN_DIRB + 2 * DN_DIRSZ <= RING_BYTES, "DeltaNet LDS map");
typedef short s16x4 __attribute__((ext_vector_type(4)));
__device__ __forceinline__ f32x4 mfma16k16(s16x4 a, s16x4 b, f32x4 c) { return __builtin_amdgcn_mfma_f32_16x16x16bf16_1k(a, b, c, 0, 0, 0); }
#define DN_LAUNDER(x_) asm volatile("" : "+v"(x_))
template <int DIR> __device__ __forceinline__ void dn_inv16(LAS unsigned char* db, int lane) {
    const int b = lane >> 4, c = lane & 15; float t[16];
    unsigned lb = (unsigned)(uintptr_t)(db + DN_LF) + (DIR == 0 ? (16 * b) * 276 : (48 - 16 * b) * 276); DN_LAUNDER(lb);
#pragma unroll
    for (int r = 0; r < 16; ++r) { float s = (r == c) ? 1.f : 0.f;
#pragma unroll
        for (int q = 0; q < 4; ++q) if (4 * q < r) { f32x4 Lr;
            if (DIR == 0) Lr = *(const LAS f32x4*)(uintptr_t)(lb + r * 272 + q * 16);
            else { const f32x4 y = *(const LAS f32x4*)(uintptr_t)(lb + (15 - r) * 272 + (12 - 4 * q) * 4); Lr = (f32x4){y[3], y[2], y[1], y[0]}; }
#pragma unroll
            for (int e = 0; e < 4; ++e) if (4 * q + e < r) s -= Lr[e] * t[4 * q + e]; }
        t[r] = s; }
    unsigned tb = (unsigned)(uintptr_t)(db + DN_TI) + b * 512 + c * 2; DN_LAUNDER(tb);
#pragma unroll
    for (int r = 0; r < 16; ++r) *(LAS bf16*)(uintptr_t)(tb + r * 32) = (bf16)f2bf(t[r]);
}
template <int DIR> __device__ __forceinline__ void dn_subst(LAS unsigned char* lds, LAS unsigned char* db, int gwv, int lane) {
    const int fr = lane & 15, fq = lane >> 4; const bool isw = gwv >= 2;
    s16x4 ti[4], al[6];
    unsigned tb = (unsigned)(uintptr_t)(db + DN_TI) + fr * 32 + fq * 8; DN_LAUNDER(tb);
#pragma unroll
    for (int bi = 0; bi < 4; ++bi) ti[bi] = *(const LAS s16x4*)(uintptr_t)(tb + bi * 512);
    unsigned lb = (unsigned)(uintptr_t)(db + DN_LF) + (DIR == 0 ? fr * 272 + fq * 16 : (15 - fr) * 272 + (12 - 4 * fq) * 4); DN_LAUNDER(lb);
#pragma unroll
    for (int bi = 1; bi < 4; ++bi)
#pragma unroll
        for (int bj = 0; bj < 3; ++bj) if (bj < bi) { f32x4 x;
            if (DIR == 0) x = *(const LAS f32x4*)(uintptr_t)(lb + (16 * bi) * 272 + (16 * bj) * 4);
            else { const f32x4 y = *(const LAS f32x4*)(uintptr_t)(lb + (48 - 16 * bi) * 272 + (48 - 16 * bj) * 4); x = (f32x4){y[3], y[2], y[1], y[0]}; }
            v2u pk; pk.x = pk2(-x[0], -x[1]); pk.y = pk2(-x[2], -x[3]); al[bi * (bi - 1) / 2 + bj] = __builtin_bit_cast(s16x4, pk); }
    unsigned sb = (unsigned)(uintptr_t)(db + DN_SC) + (DIR == 0 ? 4 * fq : 12 - 4 * fq) * 4; DN_LAUNDER(sb);
    const int cc0 = 32 * (gwv & 1) + fr;
    unsigned xb = (unsigned)(uintptr_t)(lds + (isw ? DN_TKN : DN_TVN)) + cc0 * 2 + (DIR == 0 ? 4 * fq : 12 - 4 * fq) * DN_TS; DN_LAUNDER(xb);
    unsigned rb = (unsigned)(uintptr_t)(db + (isw ? DN_WT : DN_UT)) + cc0 * DN_TS + (DIR == 0 ? 4 * fq : 12 - 4 * fq) * 2; DN_LAUNDER(rb);
#pragma unroll
    for (int tt = 0; tt < 2; ++tt) {
        f32x4 S[4], ed[4];
#pragma unroll
        for (int bi = 0; bi < 4; ++bi) { const int po = (DIR == 0 ? 16 * bi : 48 - 16 * bi);
            f32x4 be = *(const LAS f32x4*)(uintptr_t)(sb + po * 4), eg = *(const LAS f32x4*)(uintptr_t)(sb + 512 + po * 4), dd = *(const LAS f32x4*)(uintptr_t)(sb + 768 + po * 4);
            f32x4 xv;
#pragma unroll
            for (int e = 0; e < 4; ++e) xv[e] = bf1(*(const LAS bf16*)(uintptr_t)(xb + tt * 32 + (po + e) * DN_TS));
            f32x4 sv;
#pragma unroll
            for (int e = 0; e < 4; ++e) sv[e] = be[e] * (isw ? eg[e] * xv[e] : xv[e]);
            if (DIR == 0) { S[bi] = sv; ed[bi] = dd; } else { S[bi] = (f32x4){sv[3], sv[2], sv[1], sv[0]}; ed[bi] = (f32x4){dd[3], dd[2], dd[1], dd[0]}; } }
#define DN_CVT(v_) __builtin_bit_cast(s16x4, (v2u){pk2((v_)[0], (v_)[1]), pk2((v_)[2], (v_)[3])})
        const f32x4 zz = (f32x4){0.f, 0.f, 0.f, 0.f}; f32x4 X[4]; s16x4 xb0, xb1, xb2;
        X[0] = mfma16k16(ti[0], DN_CVT(S[0]), zz); xb0 = DN_CVT(X[0]);
        S[1] = mfma16k16(al[0], xb0, S[1]); X[1] = mfma16k16(ti[1], DN_CVT(S[1]), zz); xb1 = DN_CVT(X[1]);
        S[2] = mfma16k16(al[1], xb0, S[2]); S[2] = mfma16k16(al[2], xb1, S[2]); X[2] = mfma16k16(ti[2], DN_CVT(S[2]), zz); xb2 = DN_CVT(X[2]);
        S[3] = mfma16k16(al[3], xb0, S[3]); S[3] = mfma16k16(al[4], xb1, S[3]); S[3] = mfma16k16(al[5], xb2, S[3]); X[3] = mfma16k16(ti[3], DN_CVT(S[3]), zz);
#undef DN_CVT
#pragma unroll
        for (int bi = 0; bi < 4; ++bi) { const f32x4 x = X[bi]; const f32x4 xd = x * ed[bi]; const int po = (DIR == 0 ? 16 * bi : 48 - 16 * bi); v2u o, od;
            if (DIR == 0) { o.x = pk2(x[0], x[1]); o.y = pk2(x[2], x[3]); od.x = pk2(xd[0], xd[1]); od.y = pk2(xd[2], xd[3]); }
            else { o.x = pk2(x[3], x[2]); o.y = pk2(x[1], x[0]); od.x = pk2(xd[3], xd[2]); od.y = pk2(xd[1], xd[0]); }
            *(LAS v2u*)(uintptr_t)(rb + tt * 16 * DN_TS + po * 2) = o; *(LAS v2u*)(uintptr_t)(rb + 9216 + tt * 16 * DN_TS + po * 2) = od; }
    }
}

__device__ __forceinline__ void pa_thin_unit(volatile LAS unsigned* MISC, LAS unsigned char* lds, const int l, const int pm, const int wave, const int lane) {
    unsigned char* ws = WSP; const unsigned char* Hb = ws + WS_H; const unsigned char* Wt = ws + WS_WIN + ((size_t)l * NIN + 2816) * 2048; float* BG = (float*)(ws + WS_BG);
    const float* a_log = INP(18) + l * 8; const float* dt_bias = INP(19) + l * 8;
    const int fr = lane & 15, fq = lane >> 4;
    const int row0 = pm * 256 + wave * 32;
    LAS unsigned char* WL = lds;
    LAS unsigned char* XL = lds + 33024 + wave * 8704;
    { v4u wv[4];
#pragma unroll
      for (int q = 0; q < 4; ++q) wv[q] = *(const v4u*)(Wt + (size_t)(2 * wave + (q >> 1)) * 2048 + (q & 1) * 1024 + lane * 16);
#pragma unroll
      for (int q = 0; q < 4; ++q) *(LAS v4u*)(WL + (2 * wave + (q >> 1)) * 2064 + (q & 1) * 1024 + lane * 16) = wv[q]; }
    const unsigned char* xg = Hb + (size_t)(row0 + (lane >> 4)) * 2048 + (lane & 15) * 16;
    LAS unsigned char* xs = XL + (lane >> 4) * 272 + (lane & 15) * 16;
    v4u xa[8], xb[8];
#define TH_LOAD(dst_, kb_) do { _Pragma("unroll") for (int q_ = 0; q_ < 8; ++q_) dst_[q_] = *(const v4u*)(xg + (size_t)q_ * 4 * 2048 + (kb_) * 256); } while (0)
#define TH_PUT(src_) do { _Pragma("unroll") for (int q_ = 0; q_ < 8; ++q_) *(LAS v4u*)(xs + q_ * 4 * 272) = src_[q_]; } while (0)
#define TH_MMA(kb_) do { _Pragma("unroll") for (int s_ = 0; s_ < 4; ++s_) { const bf16x8 wf_ = *(const LAS bf16x8*)(WL + fr * 2064 + ((kb_) * 4 + s_) * 64 + fq * 16); \
        const bf16x8 x0_ = *(const LAS bf16x8*)(XL + fr * 272 + s_ * 64 + fq * 16), x1_ = *(const LAS bf16x8*)(XL + (16 + fr) * 272 + s_ * 64 + fq * 16); \
        acc[0] = mfma16(wf_, x0_, acc[0]); acc[1] = mfma16(wf_, x1_, acc[1]); } } while (0)
    f32x4 acc[2]; acc[0] = (f32x4){0.f, 0.f, 0.f, 0.f}; acc[1] = acc[0];
    TH_LOAD(xa, 0);
    __syncthreads();
#pragma unroll
    for (int kb = 0; kb < 8; kb += 2) {
        TH_PUT(xa); TH_LOAD(xb, kb + 1); TH_MMA(kb);
        TH_PUT(xb); if (kb + 2 < 8) TH_LOAD(xa, kb + 2); TH_MMA(kb + 1);
    }
#undef TH_LOAD
#undef TH_PUT
#undef TH_MMA
    f32x4 na, db;
    { const int jb = (fq & 1) * 4; const f32x4 a = *(const f32x4*)(a_log + jb); db = *(const f32x4*)(dt_bias + jb);
#pragma unroll
      for (int e = 0; e < 4; ++e) na[e] = -__builtin_amdgcn_exp2f(1.4426950408889634f * a[e]); }
#pragma unroll
    for (int t = 0; t < 2; ++t) { f32x4 o;
#pragma unroll
        for (int e = 0; e < 4; ++e) { const float v = acc[t][e];
            const float sg = __builtin_amdgcn_rcpf(1.0f + __builtin_amdgcn_exp2f(-1.4426950408889634f * v));
            const float xx = v + db[e];
            const float sp = fmaxf(xx, 0.f) + 0.6931471805599453f * __builtin_amdgcn_logf(1.0f + __builtin_amdgcn_exp2f(-1.4426950408889634f * fabsf(xx)));
            o[e] = fq < 2 ? sg : na[e] * sp; }
        *(f32x4*)(BG + (size_t)(row0 + 16 * t + fr) * 16 + 4 * fq) = o; }
}

__global__ void __launch_bounds__(NWAVES * 64, 2) mk_fwd(Args args) {
    extern __shared__ __attribute__((aligned(16))) unsigned char lds_raw[];
    LAS unsigned char* lds = (LAS unsigned char*)lds_raw;
    volatile LAS unsigned* MISC = (volatile LAS unsigned*)(lds + MISC_OFF);
    const int tid0 = threadIdx.x;
    const int G = gridDim.x, bid = blockIdx.x;
    const int vcu0 = (G % 8 == 0) ? (bid % 8) * (G / 8) + bid / 8 : bid;
#define PHASE_LOCALS() int tid = tid0, vcu = vcu0; asm volatile("" : "+v"(tid), "+s"(vcu)); \
    const int lane = tid & 63, wave = __builtin_amdgcn_readfirstlane(tid >> 6), fr = lane & 15, fq = lane >> 4, gw = vcu * NWAVES + wave, NGW = G * NWAVES; \
    (void)fr; (void)fq; (void)gw; (void)NGW; (void)lane; (void)wave
    for (int u = tid0; u < (LDS_BYTES - MISC_OFF) / 4; u += NWAVES * 64) ((LAS unsigned*)(lds + MISC_OFF))[u] = 0u;
    __syncthreads();
    if (tid0 < 46) ((LAS unsigned*)(lds + MISC_OFF))[32 + tid0] = ((const unsigned*)&args)[tid0];
    __syncthreads();
    XcdBarrier bar = xcd_barrier_post((unsigned*)(WSP + WS_CTL) + CW_BAR, MISC + 8);
    cg::grid_group grid = cg::this_grid();

#ifndef SKIP_P0
    asm volatile("; MARK_P0" ::: "memory");
    { PHASE_LOCALS();
    {
        unsigned char* ws = WSP; const float* w_in = INP(11); const float* w_out = INP(12); const float* pool_w = INP(13);
        bf16* Wt_in = (bf16*)(ws + WS_WIN); bf16* Wt_out = (bf16*)(ws + WS_WOUT); bf16* poolT = (bf16*)(ws + WS_POOLW); float* modv = (float*)(ws + WS_MOD); float* rope = (float*)(ws + WS_ROPE);
        const int gt = vcu * (NWAVES * 64) + tid, NGT = G * NWAVES * 64;
        for (int idx = gt; idx < 2 * 4 * 64 * 64; idx += NGT) { const int lg = idx >> 12, d = (idx >> 6) & 63, c = idx & 63; poolT[idx] = (bf16)f2bf(pool_w[(size_t)lg * 4096 + c * 64 + d]); }
        if (bid == G - 1) {
            for (int idx = tid; idx < 1024; idx += NWAVES * 64) { const int pos = idx >> 4, i = idx & 15;
                const float inv = exp2f(-(float)(2 * i) * (1.0f / 32.0f) * 13.287712379549449f); const float ang = (float)pos * inv;
                rope[idx] = cosf(ang); rope[1024 + idx] = sinf(ang); }
        }
        __syncthreads();
        const float* cvec = INP(5); const float* cctx = INP(6); const float* w_mod = INP(7); const float* b_mod = INP(8);
        if (bid < 192) {
            LAS float* sc = (LAS float*)lds;
            LAS float* red = (LAS float*)(lds + 20480);
            for (int idx = tid; idx < 5 * 1024; idx += NWAVES * 64) { const int ci = idx >> 10, k = idx & 1023; const float cv = ci == 0 ? cctx[k] : cvec[(ci - 1) * 1024 + k]; sc[idx] = fsilu(cv); }
            __syncthreads();
            const int l = bid / 96, col = (bid % 96) * 32 + (lane & 31), kh = lane >> 5;
            const float* wp = w_mod + (size_t)l * 1024 * 3072 + (size_t)(wave * 128 + kh) * 3072 + col;
            float a0 = 0.f, a1 = 0.f, a2 = 0.f, a3 = 0.f, a4 = 0.f;
            float wvs[64];
#pragma unroll
            for (int i = 0; i < 64; ++i) wvs[i] = wp[(size_t)(2 * i) * 3072];
#pragma unroll
            for (int i = 0; i < 64; ++i) { const float wv = wvs[i]; const int kk = wave * 128 + 2 * i + kh;
                a0 += sc[kk] * wv; a1 += sc[1024 + kk] * wv; a2 += sc[2048 + kk] * wv; a3 += sc[3072 + kk] * wv; a4 += sc[4096 + kk] * wv; }
            a0 += __shfl_xor(a0, 32); a1 += __shfl_xor(a1, 32); a2 += __shfl_xor(a2, 32); a3 += __shfl_xor(a3, 32); a4 += __shfl_xor(a4, 32);
            if (lane < 32) { red[(wave * 5 + 0) * 32 + lane] = a0; red[(wave * 5 + 1) * 32 + lane] = a1; red[(wave * 5 + 2) * 32 + lane] = a2; red[(wave * 5 + 3) * 32 + lane] = a3; red[(wave * 5 + 4) * 32 + lane] = a4; }
            __syncthreads();
            if (tid < 160) { const int ci = tid >> 5, c = tid & 31; float s = b_mod[l * 3072 + (bid % 96) * 32 + c];
#pragma unroll
                for (int w = 0; w < 8; ++w) s += red[(w * 5 + ci) * 32 + c];
                modv[(size_t)(l * 5 + ci) * 3072 + (bid % 96) * 32 + c] = s; }
            __syncthreads();
        }
    }
    }
#endif
    grid.sync();
#define GRID_BAR() xcd_barrier(bar)

#ifndef SKIP_PD
    asm volatile("; MARK_PD" ::: "memory");
    { PHASE_LOCALS();
        {
        unsigned char* ws = WSP; const float* w_in = INP(11); const float* w_out = INP(12);
        bf16* Wt_in = (bf16*)(ws + WS_WIN); bf16* Wt_out = (bf16*)(ws + WS_WOUT);
        LAS float* scr = (LAS float*)(lds + wave * 16384);
        constexpr int I_IN = 16 * 88, I_OUT = 16 * 32;
        if (wave >= 6)
        for (int it = vcu * 2 + (wave - 6); it < 2 * I_IN + 2 * I_OUT; it += 2 * G) {
            if (it < 2 * I_IN) {
                const int l = it / I_IN, r = it % I_IN, kb = r / 88, nb = r % 88, tile = nb >> 3, g8 = nb & 7;
                const int nlog = tile * 256 + 64 * (g8 & 3) + 32 * (g8 >> 2), nsrc = nlog < 2560 ? nlog : nlog + 16;
                p0_transpose_item(w_in + (size_t)l * 1024 * 2832, 2832, nsrc, Wt_in + (size_t)l * NIN * 1024, 1024, tile * 256 + 32 * g8, scr, 64 * kb, lane);
            } else {
                const int r2 = it - 2 * I_IN, l = r2 / I_OUT, r = r2 % I_OUT, kb = r / 32, nb = r % 32;
                p0_transpose_item(w_out + (size_t)l * 1024 * 1024, 1024, 32 * nb, Wt_out + (size_t)l * 1024 * 1024, 1024, 32 * nb, scr, 64 * kb, lane);
            }
        }
        const int gt = vcu * (NWAVES * 64) + tid, NGT = G * NWAVES * 64;
        for (int idx = gt; idx < 2 * 256 * 1024; idx += NGT) { const int l = idx >> 18, r = (idx >> 10) & 255, k = idx & 1023;
            const float v = r < 16 ? w_in[(size_t)l * 1024 * 2832 + (size_t)k * 2832 + 2560 + r] : 0.f;
            Wt_in[(size_t)l * NIN * 1024 + (size_t)(2816 + r) * 1024 + k] = (bf16)f2bf(v); }
        }
        if (wave < 6) pd_rows<4>(MISC, 0, 0, NTOK, vcu * 6 + wave, G * 6, lane);
        ctx_rows(MISC, 0, vcu * (NWAVES * 64) + tid, G * NWAVES * 64);
    }
#endif
    GRID_BAR();
    for (int l = 0; l < 2; ++l) {
#ifndef SKIP_PA
    asm volatile("; MARK_PA" ::: "memory");
    { PHASE_LOCALS();
        {
            unsigned char* ws = WSP; float* out = OUTP;
            bf16* Hb = (bf16*)(ws + WS_H); bf16* Wt_in = (bf16*)(ws + WS_WIN);
            pg8::Gemm g{Hb, Wt_in + (size_t)l * NIN * 1024, NTOK, NIN, 1024};
            {
                LAS float* tabw = (LAS float*)(lds + pg8::STAGE_BYTES); const float* rope = (const float*)(ws + WS_ROPE); const float* qn = INP(15) + l * 64; const float* kn = INP(16) + l * 64;
                for (int i = tid; i < 2048; i += NWAVES * 64) tabw[i] = rope[i];
                if (tid < 64) tabw[2048 + tid] = qn[tid]; else if (tid < 128) tabw[2048 + tid] = kn[tid - 64];
                else if (tid < 136) tabw[2176 + tid - 128] = INP(18)[l * 8 + tid - 128]; else if (tid < 144) tabw[2184 + tid - 136] = INP(19)[l * 8 + tid - 136];
                __syncthreads();
            }
            pg8::EpiIn E{ws, out + OUT_K + (size_t)l * 256 * 128, out + OUT_V + (size_t)l * 256 * 128,
                         (const LAS float*)(lds + pg8::STAGE_BYTES), 0};
            const int x = bid & 7, j = bid >> 3;
#pragma nounroll
            for (int c = 0; c < 2; ++c) {
                pg8::PaOrder S; S.x = x; S.j = j; S.r0 = 2 * c; S.nr = c == 0 ? 2 : (j < 4 ? 3 : 2);
                pg8::gemm_phase<pg8::EpiIn, pg8::PaOrder, true, true>(lds, g, S, E);
                if (c == 1 && j >= 4 && j < 16) pa_thin_unit(MISC, lds, l, 12 * x + (j < 12 ? j : j - 12), wave, lane);
                xcd_arrive(bar, 4 + 2 * l + c);
            }
        }
    }
#endif
#ifndef SKIP_PB1
        asm volatile("; MARK_SKIP_PB1" ::: "memory");
        { PHASE_LOCALS();
        {
#ifdef PROBE_PB1
            const bool dry = (rep_ == 0);
#else
            const bool dry = false;
#endif
            unsigned char* ws = WSP; bf16* X2 = (bf16*)(ws + WS_X2);
            xcd_wait(bar, 4 + 2 * l);
            const bf16* Qb = (const bf16*)(ws + WS_Q); const bf16* KPb = (const bf16*)(ws + WS_KP); const bf16* VPb = (const bf16*)(ws + WS_VP); const bf16* KSb = (const bf16*)(ws + WS_KS); const bf16* VSb = (const bf16*)(ws + WS_VS);
            for (int k = vcu; k < 512; k += G) {
                const int su = ((k & 255) >> 5) * 64 + (k & 31) + 32 * (k >> 8);
                const int xg = su >> 6, b = xg >> 1, kvh = xg & 1, h = kvh * 4 + ((su & 63) >> 4), qb = su & 15;
                const size_t r0 = (size_t)NPR + (size_t)b * 4096 + (size_t)qb * 256;
                attn_body::attn_unit<8>((const attn_body::bf16*)(Qb + r0 * 512 + h * 64), 512, (const attn_body::bf16*)(KSb + (size_t)b * 4352 * 128 + kvh * 64), (const attn_body::bf16*)(VSb + (size_t)b * 4352 * 128 + kvh * 64), 128,
                                        (attn_body::bf16*)(X2 + r0 * 1024 + 256 + h * 64), 1024, 68, (char*)lds_raw, dry);
            }
            for (int k = vcu; k < 256; k += G) {
                const int b = k >> 3, h = k & 7; const size_t r0 = (size_t)b * 256;
                attn_body::attn_unit<8>((const attn_body::bf16*)(Qb + r0 * 512 + h * 64), 512, (const attn_body::bf16*)(KPb + r0 * 128 + (h >> 2) * 64), (const attn_body::bf16*)(VPb + r0 * 128 + (h >> 2) * 64), 128,
                                        (attn_body::bf16*)(X2 + r0 * 1024 + 256 + h * 64), 1024, 4, (char*)lds_raw, dry);
            }
        }
        }
#endif
#ifndef SKIP_D1
        asm volatile("; MARK_SKIP_D1" ::: "memory");
        { PHASE_LOCALS();
        {
            unsigned char* ws = WSP; const float* conv_w = INP(17); const bf16* Zb = (const bf16*)(ws + WS_Z); const float* BG = (const float*)(ws + WS_BG); unsigned char* DN = ws + WS_DN;
            const int dir = wave >> 2, gwv = wave & 3;
            LAS unsigned char* db = lds + DN_DIRB + dir * DN_DIRSZ;
            LAS float* sc_beta = (LAS float*)(db + DN_SC); LAS float* sc_gc = sc_beta + 64; LAS float* sc_egc = sc_beta + 128; LAS float* sc_edec = sc_beta + 192; LAS float* sc_egl = sc_beta + 256;
#define DN_PREFETCH(it_) do { const int cg_ = (it_) >> 2, h_ = (it_) & 3, r0_ = cg_ * 64; \
        const int sq0_ = r0_ < NPR ? (r0_ & ~255) : NPR + ((r0_ - NPR) & ~4095), L_ = r0_ < NPR ? 256 : 4096, tb_ = r0_ - sq0_ + 8 * wave - 2; \
        const bf16* zq_ = Zb + (size_t)sq0_ * 1024 + 256 + h_ * 64 + lane; \
        bf16 rq_[11], rk_[11], rv_[11]; \
        _Pragma("unroll") for (int j_ = 0; j_ < 11; ++j_) { const int tt_ = tb_ + j_, tc_ = min(max(tt_, 0), L_ - 1); const bf16* p_ = zq_ + (size_t)tc_ * 1024; rq_[j_] = p_[0]; rk_[j_] = p_[256]; rv_[j_] = p_[512]; }     \
        _Pragma("unroll") for (int j_ = 0; j_ < 11; ++j_) { const int tt_ = tb_ + j_; const bool ok_ = (tt_ >= 0 && tt_ < L_); pfq[j_] = ok_ ? bf1(rq_[j_]) : 0.f; pfk[j_] = ok_ ? bf1(rk_[j_]) : 0.f; pfv[j_] = ok_ ? bf1(rv_[j_]) : 0.f; } \
        const float* cw_ = conv_w + (size_t)l * 4 * 768 + h_ * 64 + lane; \
        _Pragma("unroll") for (int j_ = 0; j_ < 4; ++j_) { pfw[j_] = cw_[j_ * 768]; pfw[4 + j_] = cw_[j_ * 768 + 256]; pfw[8 + j_] = cw_[j_ * 768 + 512]; } \
        const float* bg_ = BG + (size_t)(r0_ + lane) * 16; pfb[0] = bg_[dir * 4 + h_]; pfb[1] = bg_[8 + dir * 4 + h_]; } while (0)
            xcd_wait(bar, 5 + 2 * l);
            const int xj = vcu >> 5, jj = vcu & 31; int it0, itstep, itend;
            if (jj < 4) { it0 = xj * 4 + jj; itstep = 32; itend = 96; }
            else if (jj < 16) { it0 = 96 + xj * 12 + (jj - 4); itstep = 96; itend = 672; }
            else { it0 = 672 + xj * 16 + (jj - 16); itstep = 128; itend = 1536; }
            for (int it = it0; it < itend; it += itstep) {
                const int cgi = it >> 2, h = it & 3;
                {
                    float pfq[11], pfk[11], pfv[11], pfw[12], pfb[2];
                    DN_PREFETCH(it);
                    float xq[11], xk[11], xv[11], wq[4], wk[4], wv[4];
#pragma unroll
                    for (int j = 0; j < 11; ++j) { xq[j] = pfq[j]; xk[j] = pfk[j]; xv[j] = pfv[j]; }
#pragma unroll
                    for (int j = 0; j < 4; ++j) { wq[j] = pfw[j]; wk[j] = pfw[4 + j]; wv[j] = pfw[8 + j]; }
                    const float be_pf = pfb[0], g_pf = pfb[1];
#pragma unroll
                    for (int r = 0; r < 8; ++r) {
                        float yq = wq[0] * xq[r] + wq[1] * xq[r + 1] + wq[2] * xq[r + 2] + wq[3] * xq[r + 3];
                        float yk = wk[0] * xk[r] + wk[1] * xk[r + 1] + wk[2] * xk[r + 2] + wk[3] * xk[r + 3];
                        float yv = wv[0] * xv[r] + wv[1] * xv[r + 1] + wv[2] * xv[r + 2] + wv[3] * xv[r + 3];
                        yq = fsilu(yq); yk = fsilu(yk); yv = fsilu(yv);
                        const float sq = wave_sum(yq * yq), sk = wave_sum(yk * yk);
                        const float qv = yq * rsqrtf(sq + EPS) * 0.125f, kv = yk * rsqrtf(sk + EPS);
                        const int i = 8 * wave + r;
                        *(LAS bf16*)(lds + DN_TQN + i * DN_TS + lane * 2) = (bf16)f2bf(qv);
                        const bf16 kb16 = (bf16)f2bf(kv);
                        *(LAS bf16*)(lds + DN_TKN + i * DN_TS + lane * 2) = kb16;
                        *(LAS bf16*)(lds + DN_TKT + lane * DN_TS + i * 2) = kb16;
                        *(LAS bf16*)(lds + DN_TVN + i * DN_TS + lane * 2) = (bf16)f2bf(yv);
                    }
                    if (gwv == 0) {
                        int ln = lane; asm volatile("" : "+v"(ln));
                        const float be = be_pf; float gc = g_pf;
                        if (dir == 0) {
#pragma unroll
                            for (int o = 1; o < 64; o <<= 1) { const float t = __int_as_float(__builtin_amdgcn_ds_bpermute(((ln - o) & 63) << 2, __float_as_int(gc))); if (ln >= o) gc += t; }
                        } else {
#pragma unroll
                            for (int o = 1; o < 64; o <<= 1) { const float t = __int_as_float(__builtin_amdgcn_ds_bpermute(((ln + o) & 63) << 2, __float_as_int(gc))); if (ln + o < 64) gc += t; }
                        }
                        const float gl = __int_as_float(__builtin_amdgcn_ds_bpermute((dir == 0 ? 63 : 0) << 2 | (ln & 0), __float_as_int(gc)));
                        sc_beta[ln] = be; sc_gc[ln] = gc; sc_egc[ln] = __expf(gc); sc_edec[ln] = __expf(gl - gc); if (ln == 0) sc_egl[0] = __expf(gl);
                    }
                }
                __syncthreads();
                f32x4 at[4];
                {
                    const int i = 16 * gwv + fr; bf16x8 xkf[2], xqf[2];
#pragma unroll
                    for (int s = 0; s < 2; ++s) { xkf[s] = *(const LAS bf16x8*)(lds + DN_TKN + i * DN_TS + (32 * s + 8 * fq) * 2); xqf[s] = *(const LAS bf16x8*)(lds + DN_TQN + i * DN_TS + (32 * s + 8 * fq) * 2); }
                    const float gci = sc_gc[i], bei = sc_beta[i]; f32x4 LA = (f32x4){0.f, 0.f, 0.f, 0.f}, LB = LA;
#pragma unroll
                    for (int nt = 0; nt < 4; ++nt) {
                        f32x4 ga = (f32x4){0.f, 0.f, 0.f, 0.f}, qa = (f32x4){0.f, 0.f, 0.f, 0.f};
#pragma unroll
                        for (int s = 0; s < 2; ++s) { const bf16x8 wf = *(const LAS bf16x8*)(lds + DN_TKN + (16 * nt + fr) * DN_TS + (32 * s + 8 * fq) * 2); ga = mfma16(wf, xkf[s], ga); qa = mfma16(wf, xqf[s], qa); }
                        const f32x4 gcj = *(const LAS f32x4*)(sc_gc + 16 * nt + 4 * fq); f32x4 Lv;
#pragma unroll
                        for (int e = 0; e < 4; ++e) { const int j = 16 * nt + 4 * fq + e; const bool incl = dir == 0 ? (j <= i) : (j >= i);
                            const float dec = incl ? __expf(gci - gcj[e]) : 0.f;
                            Lv[e] = (j != i) ? bei * ga[e] * dec : 0.f; at[nt][e] = qa[e] * dec; }
                        *(LAS f32x4*)(db + DN_LF + i * 272 + (16 * nt + 4 * fq) * 4) = Lv;
                        if (nt == gwv) {
                            LA = Lv; const f32x4 bej = *(const LAS f32x4*)(sc_beta + 16 * nt + 4 * fq);
#pragma unroll
                            for (int e = 0; e < 4; ++e) { const int j = 16 * nt + 4 * fq + e; const bool nz = dir == 0 ? (i < j) : (i > j);
                                LB[e] = nz ? bej[e] * ga[e] * __expf(gcj[e] - gci) : 0.f; } }
                    }
                    {
#define DN_CV(v_) __builtin_bit_cast(s16x4, (v2u){pk2((v_)[0], (v_)[1]), pk2((v_)[2], (v_)[3])})
                        const f32x4 zz = (f32x4){0.f, 0.f, 0.f, 0.f};
                        const s16x4 la = DN_CV(LA), lb = DN_CV(LB);
                        const f32x4 M2 = mfma16k16(lb, la, zz), L2 = mfma16k16(la, lb, zz);
                        const s16x4 m2 = DN_CV(M2), l2 = DN_CV(L2);
                        f32x4 X;
#pragma unroll
                        for (int e = 0; e < 4; ++e) X[e] = ((4 * fq + e) == fr ? 1.f : 0.f) - LA[e];
                        X = mfma16k16(l2, DN_CV(X), X);
                        const f32x4 M4 = mfma16k16(l2, m2, zz), L4 = mfma16k16(m2, l2, zz);
                        const s16x4 m4 = DN_CV(M4), l4 = DN_CV(L4);
                        X = mfma16k16(l4, DN_CV(X), X);
                        const f32x4 L8 = mfma16k16(m4, l4, zz);
                        X = mfma16k16(DN_CV(L8), DN_CV(X), X);
                        if (dir == 0) *(LAS v2u*)(db + DN_TI + gwv * 512 + fr * 32 + fq * 8) = (v2u){pk2(X[0], X[1]), pk2(X[2], X[3])};
                        else *(LAS v2u*)(db + DN_TI + (3 - gwv) * 512 + (15 - fr) * 32 + (12 - 4 * fq) * 2) = (v2u){pk2(X[3], X[2]), pk2(X[1], X[0])};
#undef DN_CV
                    }
                }
                __syncthreads();
                if (dir == 0) dn_subst<0>(lds, db, gwv, lane); else dn_subst<1>(lds, db, gwv, lane);
                __syncthreads();
                {
                    const int i = 16 * gwv + fr;
#pragma unroll
                    for (int nt = 0; nt < 4; ++nt) { v2u o; o.x = pk2(at[nt][0], at[nt][1]); o.y = pk2(at[nt][2], at[nt][3]); *(LAS v2u*)(db + DN_LF + i * DN_TS + (16 * nt + 4 * fq) * 2) = o; }
                }
                __syncthreads();
                {
                    const LAS unsigned char* XB = gwv == 0 ? (lds + DN_TKT) : gwv == 1 ? (db + DN_UDT) : (db + DN_LF);
                    const LAS unsigned char* WB = gwv == 0 ? (db + DN_WDT) : gwv == 1 ? (lds + DN_TKT) : gwv == 2 ? (db + DN_WT) : (db + DN_UT);
                    f32x4 acc[4][4];
#pragma unroll
                    for (int mt = 0; mt < 4; ++mt)
#pragma unroll
                        for (int nt = 0; nt < 4; ++nt) acc[mt][nt] = (f32x4){0.f, 0.f, 0.f, 0.f};
#pragma unroll
                    for (int s = 0; s < 2; ++s) { bf16x8 xf[4], wf[4];
#pragma unroll
                        for (int t = 0; t < 4; ++t) { xf[t] = *(const LAS bf16x8*)(XB + (16 * t + fr) * DN_TS + (32 * s + 8 * fq) * 2); wf[t] = *(const LAS bf16x8*)(WB + (16 * t + fr) * DN_TS + (32 * s + 8 * fq) * 2); }
#pragma unroll
                        for (int mt = 0; mt < 4; ++mt)
#pragma unroll
                            for (int nt = 0; nt < 4; ++nt) acc[mt][nt] = mfma16(wf[nt], xf[mt], acc[mt][nt]); }
                    unsigned char* dn = DN + (size_t)((cgi * 4 + h) * 2 + dir) * 32768 + gwv * 8192;
                    const float egl = sc_egl[0];
                    LAS unsigned char* stg = lds + (dir == 0 ? DN_TKN : DN_TVN) + gwv * 2304;
#pragma unroll
                    for (int mt = 0; mt < 4; ++mt) { const int m = 16 * mt + fr; const float egi = sc_egc[m];
#pragma unroll
                        for (int nt = 0; nt < 4; ++nt) { f32x4 v = acc[mt][nt]; int coff = 16 * nt + 4 * fq;
                            if (gwv == 0) { coff = 32 * (nt >> 1) + 8 * fq + 4 * (nt & 1);
#pragma unroll
                                for (int e = 0; e < 4; ++e) v[e] = ((m == 16 * nt + 4 * fq + e) ? egl : 0.f) - v[e]; }
                            else if (gwv == 2) { const v2u qq = *(const LAS v2u*)(lds + DN_TQN + m * DN_TS + (16 * nt + 4 * fq) * 2);
                                v[0] = egi * bflo(qq.x) - v[0]; v[1] = egi * bfhi(qq.x) - v[1]; v[2] = egi * bflo(qq.y) - v[2]; v[3] = egi * bfhi(qq.y) - v[3]; }
                            v2u o; o.x = pk2(v[0], v[1]); o.y = pk2(v[2], v[3]);
                            *(LAS v2u*)(stg + fr * 144 + coff * 2) = o; }
#pragma unroll
                        for (int j = 0; j < 2; ++j) { const int r = (lane >> 3) + 8 * j; const v4u x = *(const LAS v4u*)(stg + r * 144 + (lane & 7) * 16); *(v4u*)(dn + (16 * mt + r) * 128 + (lane & 7) * 16) = x; } }
                }
                __syncthreads();
            }
        }
#undef DN_PREFETCH
        }
#endif
        GRID_BAR();
#ifndef SKIP_SCAN
        asm volatile("; MARK_SKIP_SCAN" ::: "memory");
        { PHASE_LOCALS();
        {
            const bool dry = false;
            unsigned char* ws = WSP; float* out = OUTP; const float* state_in = INP(4); const unsigned char* DN = ws + WS_DN; unsigned char* STb = ws + WS_Z;
            const int xq = vcu >> 5, jq = vcu & 31;
            const int rk = xq * 28 + (jq - 4);
            if (jq < 4) {
                const int sidx = xq * 4 + jq, b = sidx >> 3, h = (sidx >> 1) & 3, dir = sidx & 1, cg0 = 128 + b * 64;
#define SC_OFF(st_) ((size_t)(((cg0 + (dir ? 63 - (st_) : (st_))) * 4 + h) * 2 + dir) * 32768)
#define SC_BAR() asm volatile("s_waitcnt lgkmcnt(0)\n\ts_barrier" ::: "memory")
                const unsigned char* DNs = DN + (size_t)wave * 1024 + (size_t)((lane >> 3) * 128 + (((lane & 7) ^ ((lane >> 3) & 7)) << 4));
                LAS unsigned char* wb = lds + wave * 1024 + lane * 16;
                v4u R[8][2];
#define SC_LD(buf_, st_) do { const unsigned char* dn_ = DNs + SC_OFF(min((st_), 63)); R[buf_][0] = *(const v4u*)dn_; R[buf_][1] = *(const v4u*)(dn_ + 8192); } while (0)
#define SC_PUTB(bi_, sl_, ld_) do { *(LAS v4u*)(wb + (sl_) * 16384) = R[bi_][0]; *(LAS v4u*)(wb + (sl_) * 16384 + 8192) = R[bi_][1]; SC_LD(bi_, (ld_)); SC_BAR(); } while (0)
#define SC_PUT(k_, st_) SC_PUTB(((k_) + 1) & 7, ((k_) + 1) & 1, (st_) + 9)
                if (wave < 4) {
                    const int mt = wave;
                    f32x4 S[4];
                    { const float* sp = state_in + ((size_t)(((b * 2 + l) * 2 + dir) * 4 + h)) * 4096 + 16 * mt + fr;
#pragma unroll
                      for (int nt = 0; nt < 4; ++nt)
#pragma unroll
                          for (int e = 0; e < 4; ++e) S[nt][e] = sp[(16 * nt + 4 * fq + e) * 64]; }
#pragma unroll
                    for (int k = 0; k < 8; ++k) SC_LD(k, k);
                    LAS unsigned char* aM = lds + fr * 128; LAS unsigned char* aN = lds + 8192 + (16 * mt + fr) * 128 + 8 * (fq & 1); const int sw = fr & 7;
                    bf16x8 mfb[2][8]; v2u nfb[2][4];
#define SC_FRAG(q_) do { \
        _Pragma("unroll") for (int nt_ = 0; nt_ < 4; ++nt_) _Pragma("unroll") for (int s_ = 0; s_ < 2; ++s_) mfb[q_][nt_ * 2 + s_] = *(const LAS bf16x8*)(aM + (q_) * 16384 + nt_ * 2048 + (((4 * s_ + fq) ^ sw) << 4)); \
        _Pragma("unroll") for (int nt_ = 0; nt_ < 4; ++nt_) nfb[q_][nt_] = *(const LAS v2u*)(aN + (q_) * 16384 + (((2 * nt_ + (fq >> 1)) ^ sw) << 4)); } while (0)
                    SC_PUTB(0, 0, 8);
                    SC_FRAG(0);
                    __builtin_amdgcn_s_setprio(2);
                    for (int st = 0; st < 64; st += 8) {
#pragma unroll
                        for (int k = 0; k < 8; ++k) {
                            SC_PUT(k, st + k);
                            SC_FRAG((k + 1) & 1);
                            const bf16x8* mf = mfb[k & 1]; const v2u* nf = nfb[k & 1];
                            unsigned sw_[8];
#pragma unroll
                            for (int nt = 0; nt < 4; ++nt) { sw_[2 * nt] = pk2(S[nt][0], S[nt][1]); sw_[2 * nt + 1] = pk2(S[nt][2], S[nt][3]); }
                            { LAS unsigned char* sp_ = lds + 32768 + (k & 1) * 9216 + mt * 2304 + fr * 144 + 8 * fq;
#pragma unroll
                              for (int nt = 0; nt < 4; ++nt) *(LAS v2u*)(sp_ + 32 * nt) = (v2u){sw_[2 * nt], sw_[2 * nt + 1]}; }
                            bf16x8 xs_[2];
#pragma unroll
                            for (int s = 0; s < 2; ++s) xs_[s] = __builtin_bit_cast(bf16x8, (v4u){sw_[4 * s], sw_[4 * s + 1], sw_[4 * s + 2], sw_[4 * s + 3]});
#pragma unroll
                            for (int nt = 0; nt < 4; ++nt) { f32x4 c_ = (f32x4){bflo(nf[nt].x), bfhi(nf[nt].x), bflo(nf[nt].y), bfhi(nf[nt].y)};
                                c_ = mfma16(mf[nt * 2 + 0], xs_[0], c_); c_ = mfma16(mf[nt * 2 + 1], xs_[1], c_); S[nt] = c_; }
                        }
                    }
                    __builtin_amdgcn_s_setprio(0);
                    SC_BAR();
#undef SC_FRAG
                } else {
#pragma unroll
                    for (int k = 0; k < 8; ++k) SC_LD(k, k);
                    SC_PUTB(0, 0, 8);
                    const int c = wave - 4;
                    LAS unsigned char* gs = lds + 32768 + c * 2304 + (lane >> 3) * 144 + (lane & 7) * 16;
                    unsigned char* gd = STb + ((size_t)(16 * c + (lane >> 3)) * 1024 + 256 + (h * 2 + dir) * 64 + (lane & 7) * 8) * 2;
#define SC_OUT(kb_, s_) do { const v4u x0_ = *(const LAS v4u*)(gs + (kb_) * 9216), x1_ = *(const LAS v4u*)(gs + (kb_) * 9216 + 8 * 144); \
        unsigned char* d_ = gd + (size_t)(cg0 + (dir ? 63 - (s_) : (s_))) * (64 * 2048); *(v4u*)d_ = x0_; *(v4u*)(d_ + 8 * 2048) = x1_; } while (0)
                    for (int st = 0; st < 64; st += 8) {
#pragma unroll
                        for (int k = 0; k < 8; ++k) { SC_PUT(k, st + k); if (st + k > 0) SC_OUT((k + 1) & 1, st + k - 1); }
                    }
                    SC_BAR(); SC_OUT(1, 63);
#undef SC_OUT
                }
#undef SC_PUT
#undef SC_PUTB
#undef SC_LD
#undef SC_BAR
#undef SC_OFF
                __syncthreads();
            } else {
            if (rk < 128) {
                const int p = rk * 8 + wave, sidx = p >> 2, mt = p & 3, nch = 4, cg0 = (sidx >> 3) * 4;
                const int b = sidx >> 3, h = (sidx >> 1) & 3, dir = sidx & 1;
                f32x4 S[4];
#pragma unroll
                for (int nt = 0; nt < 4; ++nt) S[nt] = (f32x4){0.f, 0.f, 0.f, 0.f};
                bf16x8 mf[4][8]; v2u nf[4][4];
#define SC_ID(st_) ((size_t)(((cg0 + (dir ? nch - 1 - (st_) : (st_))) * 4 + h) * 2 + dir))
#define SC_LOAD(buf_, st_) do { const unsigned char* dn_ = DN + SC_ID(st_) * 32768; \
    _Pragma("unroll") for (int nt_ = 0; nt_ < 4; ++nt_) _Pragma("unroll") for (int s_ = 0; s_ < 2; ++s_) mf[buf_][nt_ * 2 + s_] = *(const bf16x8*)(dn_ + (16 * nt_ + fr) * 128 + (32 * s_ + 8 * fq) * 2); \
    _Pragma("unroll") for (int nt_ = 0; nt_ < 4; ++nt_) nf[buf_][nt_] = *(const v2u*)(dn_ + 8192 + (16 * mt + fr) * 128 + (16 * nt_ + 4 * fq) * 2); } while (0)
#define SC_STEP(buf_, st_) do { \
    unsigned sw_[8]; \
    _Pragma("unroll") for (int nt_ = 0; nt_ < 4; ++nt_) { sw_[2 * nt_] = pk2(S[nt_][0], S[nt_][1]); sw_[2 * nt_ + 1] = pk2(S[nt_][2], S[nt_][3]); } \
    { LAS unsigned char* sg_ = lds + wave * 18944 + ((st_) & 1) * 2304;        \
      _Pragma("unroll") for (int nt_ = 0; nt_ < 4; ++nt_) *(LAS v2u*)(sg_ + fr * 144 + 8 * fq + 32 * nt_) = (v2u){sw_[2 * nt_], sw_[2 * nt_ + 1]}; \
      unsigned char* sp_ = STb + ((size_t)((cg0 + (dir ? nch - 1 - (st_) : (st_))) * 64 + 16 * mt + (lane >> 3)) * 1024 + 256 + (h * 2 + dir) * 64 + (lane & 7) * 8) * 2; \
      _Pragma("unroll") for (int j_ = 0; j_ < 2; ++j_) { const v4u x_ = *(const LAS v4u*)(sg_ + ((lane >> 3) + 8 * j_) * 144 + (lane & 7) * 16); *(v4u*)(sp_ + j_ * 8 * 2048) = x_; } } \
    bf16x8 xs_[2]; \
    _Pragma("unroll") for (int s_ = 0; s_ < 2; ++s_) xs_[s_] = __builtin_bit_cast(bf16x8, (v4u){sw_[4 * s_], sw_[4 * s_ + 1], sw_[4 * s_ + 2], sw_[4 * s_ + 3]}); \
    _Pragma("unroll") for (int nt_ = 0; nt_ < 4; ++nt_) { f32x4 c_ = (f32x4){bflo(nf[buf_][nt_].x), bfhi(nf[buf_][nt_].x), bflo(nf[buf_][nt_].y), bfhi(nf[buf_][nt_].y)}; \
        c_ = mfma16(mf[buf_][nt_ * 2 + 0], xs_[0], c_); c_ = mfma16(mf[buf_][nt_ * 2 + 1], xs_[1], c_); S[nt_] = c_; } } while (0)
                SC_LOAD(0, 0); SC_LOAD(1, 1); SC_LOAD(2, 2); SC_LOAD(3, 3);
                SC_STEP(0, 0); SC_STEP(1, 1); SC_STEP(2, 2); SC_STEP(3, 3);
#undef SC_STEP
#undef SC_LOAD
#undef SC_ID
                { float* op = out + OUT_S + ((size_t)(((b * 2 + l) * 2 + dir) * 4 + h)) * 4096 + 16 * mt + fr;
#pragma unroll
                    for (int nt = 0; nt < 4; ++nt)
#pragma unroll
                        for (int e = 0; e < 4; ++e) op[(16 * nt + 4 * fq + e) * 64] = S[nt][e]; }
            }
            {
                const float* pool_scale = INP(14); bf16* X2 = (bf16*)(ws + WS_X2); const bf16* Zb = (const bf16*)(ws + WS_Z); const bf16* poolT = (const bf16*)(ws + WS_POOLW);
                const int g = wave & 3, wsz = 2 << g, half = wsz >> 1;
                const int pitA = rk * 8 + wave, pitB0 = 1792 + ((rk + 96) % 224) * 8 + wave; const bool hasB = pitB0 < 3072; const int pitB = hasB ? pitB0 : pitA;
                auto issue = [&](const int pit, v4u (&rr)[6], v4u (&gt)[4]) {
                    const int row0 = (pit >> 2) * 32, seq0 = row0 < NPR ? (row0 & ~255) : NPR + ((row0 - NPR) & ~4095), L = row0 < NPR ? 256 : 4096, tlo = row0 - seq0 - 8;
#pragma unroll
                    for (int j = 0; j < 6; ++j) { const int tc = min(max(tlo + 8 * j + (lane >> 3), 0), L - 1); rr[j] = *(const v4u*)(Zb + (size_t)(seq0 + tc) * 1024 + g * 64 + (lane & 7) * 8); }
#pragma unroll
                    for (int j = 0; j < 4; ++j) gt[j] = *(const v4u*)(X2 + (size_t)(row0 + 8 * j + (lane >> 3)) * 1024 + g * 64 + (lane & 7) * 8);
                };
                v4u rrA[6], gtA[4], rrB[6], gtB[4];
                issue(pitA, rrA, gtA); issue(pitB, rrB, gtB);
                bf16x8 wfr[2][4]; f32x4 psv[4];
                { const bf16* wp = poolT + (size_t)((l * 4 + g) * 64) * 64;
#pragma unroll
                  for (int s = 0; s < 2; ++s)
#pragma unroll
                      for (int nt = 0; nt < 4; ++nt) wfr[s][nt] = *(const bf16x8*)(wp + (size_t)(16 * nt + fr) * 64 + 32 * s + 8 * fq);
#pragma unroll
                  for (int nt = 0; nt < 4; ++nt) psv[nt] = *(const f32x4*)(pool_scale + l * 256 + g * 64 + 16 * nt + 4 * fq); }
                auto body = [&](const int pit, const v4u (&rr)[6], const v4u (&gtr)[4]) {
                    const int row0 = (pit >> 2) * 32;
                    const int seq0 = row0 < NPR ? (row0 & ~255) : NPR + ((row0 - NPR) & ~4095); const int L = row0 < NPR ? 256 : 4096;
                    LAS float* cs = (LAS float*)(lds + wave * 18944);
                    LAS unsigned char* pl = lds + wave * 18944 + 12544;
                    const int t0 = row0 - seq0, tlo = t0 - 8;
                    LAS unsigned char* raw = lds + wave * 18944;
#pragma unroll
                    for (int j = 0; j < 6; ++j) *(LAS v4u*)(raw + (8 * j + (lane >> 3)) * 128 + (lane & 7) * 16) = rr[j];
                    asm volatile("" ::: "memory");
                    bf16 xr[48];
#pragma unroll
                    for (int i = 0; i < 48; ++i) xr[i] = *(const LAS bf16*)(raw + i * 128 + lane * 2);
                    asm volatile("s_waitcnt lgkmcnt(0)" ::: "memory");
                    float run = 0.f; cs[lane] = 0.f;
#pragma unroll
                    for (int i = 0; i < 48; ++i) { const int tt = tlo + i; const float x = (tt >= 0 && tt < L) ? bf1(xr[i]) : 0.f; run += x; cs[(i + 1) * 64 + lane] = run; }
#pragma unroll
                    for (int j = 0; j < 32; ++j) { const int t = t0 + j; const int lo = max(t - half, 0), hi = min(t - half + wsz, L);
                        const float rc = 1.0f / (float)(hi - lo);
                        const float pv = (cs[(hi - tlo) * 64 + lane] - cs[(lo - tlo) * 64 + lane]) * rc - bf1(xr[j + 8]);
                        *(LAS bf16*)(pl + j * 144 + lane * 2) = (bf16)f2bf(pv); }
                    asm volatile("" ::: "memory");
                    bf16x8 xf[2][2];
#pragma unroll
                    for (int mt = 0; mt < 2; ++mt)
#pragma unroll
                        for (int s = 0; s < 2; ++s) xf[mt][s] = *(const LAS bf16x8*)(pl + (16 * mt + fr) * 144 + (32 * s + 8 * fq) * 2);
                    f32x4 acc[2][4];
#pragma unroll
                    for (int mt = 0; mt < 2; ++mt)
#pragma unroll
                        for (int nt = 0; nt < 4; ++nt) acc[mt][nt] = (f32x4){0.f, 0.f, 0.f, 0.f};
#pragma unroll
                    for (int s = 0; s < 2; ++s)
#pragma unroll
                        for (int nt = 0; nt < 4; ++nt)
#pragma unroll
                            for (int mt = 0; mt < 2; ++mt) acc[mt][nt] = mfma16(wfr[s][nt], xf[mt][s], acc[mt][nt]);
                    LAS unsigned char* og = lds + wave * 18944;
#pragma unroll
                    for (int mt = 0; mt < 2; ++mt)
#pragma unroll
                        for (int nt = 0; nt < 4; ++nt) { const f32x4 ps = psv[nt]; const f32x4 a = acc[mt][nt];
                            v2u o; o.x = pk2(a[0] * ps[0], a[1] * ps[1]); o.y = pk2(a[2] * ps[2], a[3] * ps[3]);
                            *(LAS v2u*)(og + (16 * mt + fr) * 144 + (16 * nt + 4 * fq) * 2) = o; }
#pragma unroll
                    for (int j = 0; j < 4; ++j) { const v4u x = *(const LAS v4u*)(og + (8 * j + (lane >> 3)) * 144 + (lane & 7) * 16); const v4u gt = gtr[j]; v4u o;
#pragma unroll
                        for (int e = 0; e < 4; ++e) o[e] = pk2(bflo(x[e]) * bflo(gt[e]), bfhi(x[e]) * bfhi(gt[e]));
                        *(v4u*)(X2 + (size_t)(row0 + 8 * j + (lane >> 3)) * 1024 + g * 64 + (lane & 7) * 8) = dry ? gt : o; }
                    asm volatile("s_waitcnt lgkmcnt(0)" ::: "memory");
                };
                body(pitA, rrA, gtA);
                if (hasB) body(pitB, rrB, gtB);
            }
            }
        }
        }
#endif
        GRID_BAR();
#ifndef SKIP_D3
        asm volatile("; MARK_SKIP_D3" ::: "memory");
        { PHASE_LOCALS();
        {
#ifdef PROBE_D3
            const bool dry = (rep_ == 0);
#else
            const bool dry = false;
#endif
            unsigned char* ws = WSP; const float* o_norm = INP(20); const unsigned char* DN = ws + WS_DN; const unsigned char* STb = ws + WS_Z; bf16* X2 = (bf16*)(ws + WS_X2);
            LAS unsigned char* SST = lds;
            LAS unsigned char* wv = lds + 36864 + wave * 13824;
            const int r8 = lane >> 3, c8 = lane & 7;
            const int pr = wave >> 2, h = (vcu & 1) * 2 + pr, mt = wave & 3;
            v4u sx[4], px[2][2], rx[2][2], gx[2]; f32x4 onv[4];
#pragma unroll
            for (int nt = 0; nt < 4; ++nt) onv[nt] = *(const f32x4*)(o_norm + l * 64 + 16 * nt + 4 * fq);
            auto issue = [&](const int it) {
                const int cgi = (vcu >> 1) + 128 * it; const size_t id0 = (size_t)((cgi * 4 + h) * 2);
                { const int ds = (wave >> 1) & 1; const unsigned char* st = STb + ((size_t)(cgi * 64 + 32 * (wave & 1) + r8) * 1024 + 256 + (h * 2 + ds) * 64 + c8 * 8) * 2;
#pragma unroll
                  for (int j = 0; j < 4; ++j) sx[j] = *(const v4u*)(st + (size_t)j * 8 * 2048); }
#pragma unroll
                for (int d = 0; d < 2; ++d) { const unsigned char* dn = DN + (id0 + d) * 32768 + (16 * mt + r8) * 128 + c8 * 16;
#pragma unroll
                    for (int j = 0; j < 2; ++j) { px[d][j] = *(const v4u*)(dn + 16384 + j * 1024); rx[d][j] = *(const v4u*)(dn + 24576 + j * 1024); } }
                const bf16* xr_ = X2 + (size_t)(cgi * 64 + 16 * mt + r8) * 1024 + 768 + h * 64 + c8 * 8;
#pragma unroll
                for (int j = 0; j < 2; ++j) gx[j] = *(const v4u*)(xr_ + (size_t)j * 8 * 1024);
            };
            issue(0);
#pragma unroll
            for (int it = 0; it < 3; ++it) {
                const int cgi = (vcu >> 1) + 128 * it;
                bf16* xrow = X2 + (size_t)(cgi * 64 + 16 * mt + r8) * 1024 + 768 + h * 64 + c8 * 8;
                __syncthreads();
#pragma unroll
                for (int j = 0; j < 4; ++j) *(LAS v4u*)(SST + (wave >> 1) * 9216 + (32 * (wave & 1) + 8 * j + r8) * 144 + c8 * 16) = sx[j];
#pragma unroll
                for (int d = 0; d < 2; ++d)
#pragma unroll
                    for (int j = 0; j < 2; ++j) { *(LAS v4u*)(wv + d * 2304 + (8 * j + r8) * 144 + c8 * 16) = px[d][j]; *(LAS v4u*)(wv + 4608 + d * 2304 + (8 * j + r8) * 144 + c8 * 16) = rx[d][j]; }
                const v4u g0 = gx[0], g1 = gx[1];
                if (it < 2) issue(it + 1);
                __syncthreads();
                f32x4 acc[4];
#pragma unroll
                for (int nt = 0; nt < 4; ++nt) { const v2u r0 = *(const LAS v2u*)(wv + 4608 + fr * 144 + (16 * nt + 4 * fq) * 2), r1 = *(const LAS v2u*)(wv + 4608 + 2304 + fr * 144 + (16 * nt + 4 * fq) * 2);
                    acc[nt] = (f32x4){bflo(r0.x) + bflo(r1.x), bfhi(r0.x) + bfhi(r1.x), bflo(r0.y) + bflo(r1.y), bfhi(r0.y) + bfhi(r1.y)}; }
#pragma unroll
                for (int d = 0; d < 2; ++d)
#pragma unroll
                    for (int s = 0; s < 2; ++s) { const bf16x8 pf = *(const LAS bf16x8*)(wv + d * 2304 + fr * 144 + 64 * s + 16 * fq);
#pragma unroll
                        for (int nt = 0; nt < 4; ++nt) { const bf16x8 sf = *(const LAS bf16x8*)(SST + (pr * 2 + d) * 9216 + (16 * nt + fr) * 144 + 64 * s + 16 * fq); acc[nt] = mfma16(sf, pf, acc[nt]); } }
                float ss = 0.f;
#pragma unroll
                for (int nt = 0; nt < 4; ++nt) ss += (acc[nt][0] * acc[nt][0] + acc[nt][1] * acc[nt][1]) + (acc[nt][2] * acc[nt][2] + acc[nt][3] * acc[nt][3]);
                ss += __shfl_xor(ss, 16); ss += __shfl_xor(ss, 32);
                const float rinv = rsqrtf(ss * (1.0f / 64.0f) + EPS);
#pragma unroll
                for (int nt = 0; nt < 4; ++nt) { const f32x4 on = onv[nt];
                    v2u o; o.x = pk2(acc[nt][0] * rinv * on[0], acc[nt][1] * rinv * on[1]); o.y = pk2(acc[nt][2] * rinv * on[2], acc[nt][3] * rinv * on[3]);
                    *(LAS v2u*)(wv + 9216 + fr * 144 + (16 * nt + 4 * fq) * 2) = o; }
#pragma unroll
                for (int j = 0; j < 2; ++j) { const v4u x = *(const LAS v4u*)(wv + 9216 + (8 * j + r8) * 144 + c8 * 16); const v4u gt = j == 0 ? g0 : g1; v4u o;
#pragma unroll
                    for (int e = 0; e < 4; ++e) o[e] = pk2(bflo(x[e]) * bflo(gt[e]), bfhi(x[e]) * bfhi(gt[e]));
                    *(v4u*)(xrow + (size_t)j * 8 * 1024) = dry ? gt : o; }
            }
        }
        }
#endif
        GRID_BAR();
#ifndef SKIP_PC
    asm volatile("; MARK_PC" ::: "memory");
    { PHASE_LOCALS();
        {
            unsigned char* ws = WSP; bf16* X2 = (bf16*)(ws + WS_X2); bf16* Wt_out = (bf16*)(ws + WS_WOUT); bf16* Yb = (bf16*)(ws + WS_Z); float* SS = (float*)(ws + WS_SS);
            pg8::Gemm g{X2, Wt_out + (size_t)l * 1024 * 1024, NTOK, 1024, 1024};
            pg8::EpiOut E{Yb, SS};
            const int x = bid & 7, j = bid >> 3;
            const bool isP = j >= 16;
#pragma nounroll
            for (int r = 0; r < 2; ++r) {
                pg8::OneSched S; S.pm = r == 0 ? 8 * x + (j & 7) : 64 + 4 * x + (j & 3); S.pn = r == 0 ? (j >> 3) : (j >> 2);
                pg8::gemm_phase<pg8::EpiOut, pg8::OneSched, true, true>(lds, g, S, E);
                xcd_arrive(bar, 2 * l + r);
                if (r == 0 && isP) { xcd_arrive(bar, 2 * l + 1); break; }
            }
            xcd_wait(bar, 2 * l);
            const int wrk = (x * 16 + (j & 15)) * NWAVES + wave;
#pragma nounroll
            for (int s = 0; s < 2; ++s) {
                if (s == 1) { if (!isP) break; xcd_wait(bar, 2 * l + 1); }
                const int rb = s == 1 ? 16384 : (isP ? 0 : 8192);
                pd_rows<8>(MISC, l + 1, rb, rb + 8192, wrk, 128 * NWAVES, lane);
            }
            if (l == 0) ctx_rows(MISC, 1, vcu * (NWAVES * 64) + tid, G * NWAVES * 64);
        }
    }
#endif
        if (l == 1) break;
        GRID_BAR();
    }
}

extern "C" void kernel_launch(void* const* d_in, const int* in_sizes, int n_in, void* d_out, int out_size, void* d_ws, size_t ws_size, hipStream_t stream) {
    static int grid = 0;
    if (grid == 0) {
        if (n_in != 21 || ws_size < WS_END) { fprintf(stderr, "kernel_launch: unexpected n_in %d or ws %zu\n", n_in, ws_size); grid = -1; return; }
        int dev = 0, cus = 0, per_cu = 0;
        if (hipGetDevice(&dev) != hipSuccess || hipDeviceGetAttribute(&cus, hipDeviceAttributeMultiprocessorCount, dev) != hipSuccess) { grid = -1; return; }
        if (hipFuncSetAttribute((const void*)mk_fwd, hipFuncAttributeMaxDynamicSharedMemorySize, LDS_BYTES) != hipSuccess) { fprintf(stderr, "kernel_launch: hipFuncSetAttribute failed\n"); grid = -1; return; }
        if (hipOccupancyMaxActiveBlocksPerMultiprocessor(&per_cu, (const void*)mk_fwd, NWAVES * 64, LDS_BYTES) != hipSuccess || per_cu < 1) { fprintf(stderr, "kernel_launch: occupancy query says %d\n", per_cu); (void)hipGetLastError(); per_cu = 1; }
        grid = cus;
        if (grid != 256) { fprintf(stderr, "kernel_launch: the phase schedules are laid out for 256 CUs, found %d\n", cus); grid = -1; return; }
    }
    if (grid < 0) return;
    (void)hipMemsetAsync((char*)d_ws + WS_CTL, 0, CTL_ZERO_BYTES, stream);
    Args a{};
    for (int i = 0; i < 21; ++i) a.in[i] = (const float*)d_in[i];
    a.out = (float*)d_out; a.ws = (unsigned char*)d_ws;
    void* kargs[] = {&a};
    hipError_t e = hipLaunchCooperativeKernel((const void*)mk_fwd, dim3(grid), dim3(NWAVES * 64), kargs, LDS_BYTES, stream);
    if (e != hipSuccess) fprintf(stderr, "cooperative launch failed: %s (grid %d)\n", hipGetErrorString(e), grid);
}
```

```cpp
#include <hip/hip_runtime.h>
#include <hip/hip_cooperative_groups.h>
#include <hip/hip_bf16.h>
#include <cstdio>
#include <cstdint>
#include <cmath>
namespace cg = cooperative_groups;
constexpr int NWAVES = 8;
constexpr int DMOD = 1024, NPR = 8192, NSM = 16384, NTOK = 24576, NIN = 3072;
constexpr float EPS = 1e-6f;
constexpr size_t MiB = 1u << 20;
constexpr size_t WS_CTL = 0, CTL_ZERO_BYTES = 64 * 1024;
constexpr size_t WS_WIN = 1 * MiB;
constexpr size_t WS_WOUT = 13 * MiB;
constexpr size_t WS_POOLW = 17 * MiB;
constexpr size_t WS_MOD = 17 * MiB + 128 * 1024;
constexpr size_t WS_ROPE = 17 * MiB + 256 * 1024;
constexpr size_t WS_BG = 18 * MiB;
constexpr size_t WS_SS = 18 * MiB + 1536 * 1024;
constexpr size_t WS_X2 = 21 * MiB;
constexpr size_t WS_Z = 69 * MiB;
constexpr size_t WS_R4 = 117 * MiB;
constexpr size_t WS_H = WS_R4, WS_DN = WS_R4;
constexpr size_t WS_Q = WS_R4 + 96 * MiB, WS_KP = WS_R4 + 120 * MiB, WS_VP = WS_R4 + 122 * MiB, WS_KS = WS_R4 + 124 * MiB, WS_VS = WS_R4 + 129 * MiB, WS_END = WS_R4 + 134 * MiB;
static_assert(WS_END <= 256 * MiB, "ws map");
constexpr int CW_BAR = 1024;
constexpr size_t OUT_Y = 0, OUT_K = 25165824, OUT_V = 27262976, OUT_S = 29360128;
constexpr int RING_BYTES = 155648;
constexpr int MISC_OFF = RING_BYTES, LDS_BYTES = RING_BYTES + 512;

namespace pg8 {
#define PG8_LAS __attribute__((address_space(3)))
typedef unsigned short bf16_t;
typedef short bf16x8 __attribute__((ext_vector_type(8)));
typedef float f32x4 __attribute__((ext_vector_type(4)));
typedef unsigned u32x4 __attribute__((ext_vector_type(4)));
constexpr int BM = 256, BK = 64, HALF = 128, HTB = HALF * BK * 2  , STAGE_BYTES = 8 * HTB, NXCD = 8, WGM = 8;

__host__ __device__ __forceinline__ int lds_byte(int r, int c) { const int st = (r >> 4) * 2 + (c >> 5), rr = r & 15, cc = c & 31, ob = rr * 64 + cc * 2; return st * 1024 + (ob ^ (((ob >> 9) & 1) << 5)); }
__host__ __device__ __forceinline__ void stage_rc(int b, int& R, int& C) { const int st = b / 1024, sb = b % 1024, swz = sb ^ (((sb >> 9) & 1) << 5); R = (st >> 1) * 16 + swz / 64; C = (st & 1) * 32 + (swz % 64) / 2; }
__host__ __device__ __forceinline__ int perm32(int rho) { const int n = rho >> 4, i = rho & 15; return 8 * (i >> 2) + 4 * n + (i & 3); }

struct Unit { int pm, pn; };
struct Gemm { const bf16_t* A; const bf16_t* Bt; int M, N, K; };

struct StaticOrder {
    int nM, nN, nwg, G, c;
    __host__ __device__ void init(int M, int N, int G_, int c_) { nM = M / BM; nN = N / BM; nwg = nM * nN; G = G_; c = c_; }
    __host__ __device__ bool next(int i, Unit& u) const {
        const long L = (long)i * G + c; if (L >= nwg) return false;
        int wgid = (int)L; { const int q = nwg / NXCD, r = nwg % NXCD, xcd = wgid % NXCD, off = wgid / NXCD; wgid = (xcd < r ? xcd * (q + 1) : r * (q + 1) + (xcd - r) * q) + off; }
        const int nig = WGM * nN, gid = wgid / nig, fm = gid * WGM, gsz = (nM - fm) < WGM ? (nM - fm) : WGM;
        u.pm = fm + ((wgid % nig) % gsz); u.pn = (wgid % nig) / gsz; return true;
    }
    __device__ __forceinline__ void a_ready(const Unit&) const {}
    __device__ __forceinline__ void done(const Unit&) const {}
};

struct PaOrder {
    int x, j, r0, nr;
    __device__ __forceinline__ bool next(int i, Unit& u) const {
        if (i >= nr) return false;
        const int wg = x * 144 + (r0 + i) * 32 + j, grp = wg / 96, idx = wg - 96 * grp, ci = idx >> 3;
        u.pm = grp * 8 + (idx & 7); u.pn = ci < 4 ? ci + 2 : (ci < 6 ? ci - 4 : ci); return true; }
    __device__ __forceinline__ void a_ready(const Unit&) const {}
    __device__ __forceinline__ void done(const Unit&) const {}
};
struct OneSched {
    int pm, pn;
    __device__ __forceinline__ bool next(int i, Unit& u) const { if (i > 0) return false; u.pm = pm; u.pn = pn; return true; }
    __device__ __forceinline__ void a_ready(const Unit&) const {}
    __device__ __forceinline__ void done(const Unit&) const {}
};

__device__ __forceinline__ unsigned cvt_pk_bf16(float lo, float hi) { unsigned r; asm volatile("v_cvt_pk_bf16_f32 %0, %1, %2" : "=v"(r) : "v"(lo), "v"(hi)); return r; }
typedef float f32x2 __attribute__((ext_vector_type(2)));
__device__ __forceinline__ float silu_f(float x) { return x * __builtin_amdgcn_rcpf(1.0f + __builtin_amdgcn_exp2f(-1.4426950408889634f * x)); }
__device__ __forceinline__ float softplus_f(float x) { return fmaxf(x, 0.f) + log1pf(__expf(-fabsf(x))); }
__device__ __forceinline__ u32x4 pack8(const float (&v)[8]) { u32x4 w; w.x = cvt_pk_bf16(v[0], v[1]); w.y = cvt_pk_bf16(v[2], v[3]); w.z = cvt_pk_bf16(v[4], v[5]); w.w = cvt_pk_bf16(v[6], v[7]); return w; }
struct EpiIn {
    static constexpr bool PERM = true, AFTER_DRAIN = false;
    unsigned char* ws; float* outK; float* outV;
    const PG8_LAS float* tab;
    int nostore;
    __device__ __forceinline__ void operator()(const f32x4 (&acc)[2][2][4][2], const Unit& u, int wr, int wc, int fr_in, int fq_in) const {
        int fr = fr_in, fq = fq_in; asm volatile("" : "+v"(fr), "+v"(fq));
        const int pn = u.pn, pm = u.pm;
        const int rowb = pm * BM + wr * 64 + fr;
        if (pn == 0 || pn == 1 || (pn >= 5 && pn != 11)) {
            bf16_t* dst; int colb; bool act;
            if (pn == 0) { dst = (bf16_t*)(ws + WS_Z); colb = 0; act = false; }
            else if (pn >= 7 && pn <= 9) { dst = (bf16_t*)(ws + WS_Z); colb = 256 + (pn - 7) * 256; act = false; }
            else if (pn == 1) { dst = (bf16_t*)(ws + WS_X2); colb = 0; act = true; }
            else if (pn == 10) { dst = (bf16_t*)(ws + WS_X2); colb = 768; act = true; }
            else { dst = (bf16_t*)(ws + WS_X2); colb = 256 + (pn - 5) * 256; act = true; }
            colb += 64 * wc + 8 * fq;
#pragma unroll
            for (int ai = 0; ai < 2; ++ai)
#pragma unroll
                for (int m = 0; m < 4; ++m) { bf16_t* rowp = dst + (size_t)(rowb + ai * HALF + m * 16) * 1024 + colb;
#pragma unroll
                    for (int bj = 0; bj < 2; ++bj) { float v[8];
#pragma unroll
                        for (int e = 0; e < 8; ++e) { const float x = acc[ai][bj][m][e >> 2][e & 3]; v[e] = act ? silu_f(x) : x; }
                        if (!nostore) { *(u32x4*)(rowp + bj * 32) = pack8(v); } } }
        } else if (pn == 11) {
            if (wc == 0 && fq < 2) {
                float* BG = (float*)(ws + WS_BG);
                f32x4 na[2], db[2];
#pragma unroll
                for (int n = 0; n < 2; ++n) { const f32x4 a = *(const PG8_LAS f32x4*)(tab + 2176 + 4 * n); db[n] = *(const PG8_LAS f32x4*)(tab + 2184 + 4 * n);
#pragma unroll
                    for (int e = 0; e < 4; ++e) na[n][e] = -__builtin_amdgcn_exp2f(1.4426950408889634f * a[e]); }
#pragma unroll
                for (int ai = 0; ai < 2; ++ai)
#pragma unroll
                    for (int m = 0; m < 4; ++m) { const int row = rowb + ai * HALF + m * 16; float* bp = BG + (size_t)row * 16 + 8 * fq;
#pragma unroll
                        for (int n = 0; n < 2; ++n) { const f32x4 v = acc[ai][0][m][n]; f32x4 o;
#pragma unroll
                            for (int e = 0; e < 4; ++e) {
                                const float sg = __builtin_amdgcn_rcpf(1.0f + __builtin_amdgcn_exp2f(-1.4426950408889634f * v[e]));
                                const float x = v[e] + db[n][e];
                                const float sp = fmaxf(x, 0.f) + 0.6931471805599453f * __builtin_amdgcn_logf(1.0f + __builtin_amdgcn_exp2f(-1.4426950408889634f * fabsf(x)));
                                o[e] = fq == 0 ? sg : na[n][e] * sp; }
                            if (!nostore) { *(f32x4*)(bp + 4 * n) = o; } } }
            }
        } else {
            const bool isq = (pn != 4), isk = (pn == 4 && wc < 2), latent = (pm >= 32), nrm = isq || isk, roped = latent && nrm;
            const PG8_LAS float* nw = tab + (isq ? 2048 : 2112); const PG8_LAS float* rope = tab;
            const float osc = isq ? 0.125f * 1.4426950408889634f : 1.0f;
            const int kvh = wc & 1;
#pragma unroll
            for (int ai = 0; ai < 2; ++ai)
#pragma unroll
                for (int m = 0; m < 4; ++m) {
                    const int row = rowb + ai * HALF + m * 16;
                    float rinv = 1.0f;
                    if (nrm) { float ss = 0.f;
#pragma unroll
                        for (int bj = 0; bj < 2; ++bj)
#pragma unroll
                            for (int n = 0; n < 2; ++n) { const f32x4 x = acc[ai][bj][m][n]; ss += (x[0] * x[0] + x[1] * x[1]) + (x[2] * x[2] + x[3] * x[3]); }
                        ss += __shfl_xor(ss, 16); ss += __shfl_xor(ss, 32);
                        rinv = rsqrtf(ss * (1.0f / 64.0f) + 1e-6f) * osc; }
                    const int t = latent ? ((row - 8192) & 4095) : (row & 255);
#pragma unroll
                    for (int bj = 0; bj < 2; ++bj) {
                        float v[8];
#pragma unroll
                        for (int e = 0; e < 8; ++e) v[e] = acc[ai][bj][m][e >> 2][e & 3];
                        if (nrm) { const f32x4 g0 = *(const PG8_LAS f32x4*)(nw + 32 * bj + 8 * fq), g1 = *(const PG8_LAS f32x4*)(nw + 32 * bj + 8 * fq + 4);
#pragma unroll
                            for (int e = 0; e < 4; ++e) { v[e] = v[e] * rinv * g0[e]; v[4 + e] = v[4 + e] * rinv * g1[e]; } }
                        if (roped) { const int pos = bj ? (t & 63) : (t >> 6);
                            const f32x4 c4 = *(const PG8_LAS f32x4*)(rope + pos * 16 + 4 * fq), s4 = *(const PG8_LAS f32x4*)(rope + 1024 + pos * 16 + 4 * fq);
#pragma unroll
                            for (int p = 0; p < 4; ++p) { const float x1 = v[2 * p], x2 = v[2 * p + 1]; v[2 * p] = x1 * c4[p] - x2 * s4[p]; v[2 * p + 1] = x1 * s4[p] + x2 * c4[p]; } }
                        if (isq) {
                            if (!nostore) { *(u32x4*)((bf16_t*)(ws + WS_Q) + (size_t)row * 512 + ((pn - 2) * 4 + wc) * 64 + 8 * fq + bj * 32) = pack8(v); }
                        } else if (!latent) {
                            const int b = row >> 8;
                            float* op = (isk ? outK : outV) + (size_t)b * (2 * 256 * 128) + (size_t)t * 128 + kvh * 64 + 8 * fq + bj * 32;
                            if (!nostore) { *(f32x4*)op = (f32x4){v[0], v[1], v[2], v[3]}; *(f32x4*)(op + 4) = (f32x4){v[4], v[5], v[6], v[7]}; }
                            if (!nostore) { *(u32x4*)((bf16_t*)(ws + (isk ? WS_KP : WS_VP)) + (size_t)row * 128 + kvh * 64 + 8 * fq + bj * 32) = pack8(v); }
                        } else {
                            const int b = (row - 8192) >> 12;
                            if (!nostore) { *(u32x4*)((bf16_t*)(ws + (isk ? WS_KS : WS_VS)) + ((size_t)b * 4352 + t) * 128 + kvh * 64 + 8 * fq + bj * 32) = pack8(v); }
                        }
                    }
                }
        }
    }
};
struct EpiOut {
    static constexpr bool PERM = true, AFTER_DRAIN = false;
    bf16_t* Y; float* SS;
    __device__ __forceinline__ void operator()(const f32x4 (&acc)[2][2][4][2], const Unit& u, int wr, int wc, int fr_in, int fq_in) const {
        int fr = fr_in, fq = fq_in; asm volatile("" : "+v"(fr), "+v"(fq));
        const int rowb = u.pm * BM + wr * 64 + fr, colb = u.pn * BM + wc * 32 + 8 * fq;
#pragma unroll
        for (int ai = 0; ai < 2; ++ai)
#pragma unroll
            for (int m = 0; m < 4; ++m) { const int row = rowb + ai * HALF + m * 16; bf16_t* rowp = Y + (size_t)row * 1024 + colb; float ss = 0.f;
#pragma unroll
                for (int bj = 0; bj < 2; ++bj) { const f32x4 v0 = acc[ai][bj][m][0], v1 = acc[ai][bj][m][1];
                    ss += (v0[0] * v0[0] + v0[1] * v0[1]) + (v0[2] * v0[2] + v0[3] * v0[3]) + (v1[0] * v1[0] + v1[1] * v1[1]) + (v1[2] * v1[2] + v1[3] * v1[3]);
                    u32x4 w; w.x = cvt_pk_bf16(v0[0], v0[1]); w.y = cvt_pk_bf16(v0[2], v0[3]); w.z = cvt_pk_bf16(v1[0], v1[1]); w.w = cvt_pk_bf16(v1[2], v1[3]);
                    *(u32x4*)(rowp + bj * HALF) = w; }
                ss += __shfl_xor(ss, 16); ss += __shfl_xor(ss, 32);
                if (fq == 0) SS[(size_t)row * 16 + u.pn * 4 + wc] = ss; }
    }
};

struct EpiNull {
    static constexpr bool PERM = true, AFTER_DRAIN = false;
    float* sink;
    __device__ __forceinline__ void operator()(const f32x4 (&acc)[2][2][4][2], const Unit& u, int wr, int wc, int fr, int fq) const {
        float s = 0.f;
#pragma unroll
        for (int ai = 0; ai < 2; ++ai)
#pragma unroll
            for (int bj = 0; bj < 2; ++bj)
#pragma unroll
                for (int m = 0; m < 4; ++m)
#pragma unroll
                    for (int n = 0; n < 2; ++n) s += (acc[ai][bj][m][n][0] + acc[ai][bj][m][n][1]) + (acc[ai][bj][m][n][2] + acc[ai][bj][m][n][3]);
        if (s != s) sink[u.pm * 12 + u.pn] = s;
    }
};

template <class Epi, class Sched, bool ALIGN_EPI = false, bool SP2 = false>
__device__ __forceinline__ void gemm_phase(PG8_LAS unsigned char* lds, const Gemm g, const Sched& S, const Epi& E) {
    int tid_l = threadIdx.x; asm volatile("" : "+v"(tid_l));
    const int tid = tid_l, wid = __builtin_amdgcn_readfirstlane(tid >> 6), lane = tid & 63, wr = wid >> 2, wc = wid & 3, fr = lane & 15, fq = lane >> 4;
    const int K = g.K, nt = K / BK;
    unsigned voffA[2], voffB[2];
#pragma unroll
    for (int i = 0; i < 2; ++i) { int R, C; stage_rc(tid * 16 + i * 8192, R, C); const int Rb = Epi::PERM ? ((R & ~31) + perm32(R & 31)) : R;
        voffA[i] = (unsigned)(R * K + C) * 2u; voffB[i] = (unsigned)(Rb * K + C) * 2u; }
    const size_t kstep = (size_t)(BK * 2);
    const size_t hstep = (size_t)HALF * K * 2;
    const size_t tstep = 2 * hstep;
    const unsigned ldsw = (unsigned)wid * 1024u;
    const int aoff = lds_byte(wr * 64 + fr, fq * 8), boff = lds_byte(wc * 32 + fr, fq * 8);
#define PG8_SA(b, h) (((b) * 2 + (h)) * HTB)
#define PG8_SB(b, h) ((4 + (b) * 2 + (h)) * HTB)
#define PG8_STAGE(bufoff, gbase, voff) do { _Pragma("unroll") for (int _i = 0; _i < 2; ++_i) \
        __builtin_amdgcn_global_load_lds((const unsigned*)((const char*)(gbase) + (voff)[_i]), (PG8_LAS unsigned*)(lds + (bufoff) + ldsw + _i * 8192), 16, 0, 0); } while (0)
#define PG8_LDA(dst, b, h) do { _Pragma("unroll") for (int m = 0; m < 4; ++m) _Pragma("unroll") for (int k = 0; k < 2; ++k) dst[m][k] = *(const PG8_LAS bf16x8*)(lds + PG8_SA(b, h) + aoff + m * 2048 + k * 1024); } while (0)
#define PG8_LDB(dst, b, h) do { _Pragma("unroll") for (int n = 0; n < 2; ++n) _Pragma("unroll") for (int k = 0; k < 2; ++k) dst[n][k] = *(const PG8_LAS bf16x8*)(lds + PG8_SB(b, h) + boff + n * 2048 + k * 1024); } while (0)
#define PG8_MMA(ai, bj, At, Bt) do { __builtin_amdgcn_s_setprio(1); _Pragma("unroll") for (int m = 0; m < 4; ++m) _Pragma("unroll") for (int n = 0; n < 2; ++n) _Pragma("unroll") for (int k = 0; k < 2; ++k) \
        acc[ai][bj][m][n] = __builtin_amdgcn_mfma_f32_16x16x32_bf16(Bt[n][k], At[m][k], acc[ai][bj][m][n], 0, 0, 0); __builtin_amdgcn_s_setprio(0); } while (0)
#define PG8_WAIT_V(n) asm volatile("s_waitcnt vmcnt(" #n ")" ::: "memory")
#define PG8_WAIT_L(n) asm volatile("s_waitcnt lgkmcnt(" #n ")" ::: "memory")
#define PG8_BAR __builtin_amdgcn_s_barrier()
#define PG8_SCHED __builtin_amdgcn_sched_barrier(0)
    Unit cur, nxt; int ui = 0;
    if (!S.next(0, cur)) return;
    f32x4 acc[2][2][4][2];
#pragma unroll
    for (int a = 0; a < 2; ++a)
#pragma unroll
        for (int b = 0; b < 2; ++b)
#pragma unroll
            for (int m = 0; m < 4; ++m)
#pragma unroll
                for (int n = 0; n < 2; ++n) acc[a][b][m][n] = (f32x4){0.f, 0.f, 0.f, 0.f};
    bf16x8 At[4][2], B0[2][2], B1[2][2];
    const char* cA = (const char*)g.A + (size_t)cur.pm * tstep; const char* cB = (const char*)g.Bt + (size_t)cur.pn * tstep;
    S.a_ready(cur);
    if constexpr (SP2) {
        PG8_STAGE(PG8_SB(0, 0), cB, voffB); PG8_STAGE(PG8_SB(0, 1), cB + hstep, voffB); PG8_STAGE(PG8_SA(0, 0), cA, voffA); PG8_STAGE(PG8_SA(0, 1), cA + hstep, voffA);
        if (wr == 1) PG8_BAR;
        PG8_WAIT_V(2); PG8_BAR;
        PG8_STAGE(PG8_SB(1, 0), cB + kstep, voffB); PG8_STAGE(PG8_SA(1, 0), cA + kstep, voffA); PG8_STAGE(PG8_SB(1, 1), cB + hstep + kstep, voffB);
        PG8_WAIT_V(6); PG8_BAR;
    } else {
        PG8_STAGE(PG8_SB(0, 0), cB, voffB); PG8_STAGE(PG8_SA(0, 0), cA, voffA); PG8_STAGE(PG8_SB(0, 1), cB + hstep, voffB); PG8_STAGE(PG8_SA(0, 1), cA + hstep, voffA);
        if (wr == 1) PG8_BAR;
        PG8_WAIT_V(4); PG8_BAR;
        PG8_STAGE(PG8_SB(1, 0), cB + kstep, voffB); PG8_STAGE(PG8_SA(1, 0), cA + kstep, voffA); PG8_STAGE(PG8_SB(1, 1), cB + hstep + kstep, voffB);
        PG8_WAIT_V(6); PG8_BAR;
    }
    for (;;) {
        const bool has_next = S.next(ui + 1, nxt);
        const char* nA = has_next ? (const char*)g.A + (size_t)nxt.pm * tstep : cA; const char* nB = has_next ? (const char*)g.Bt + (size_t)nxt.pn * tstep : cB;
        for (int t = 0; t < nt; t += 2) {
            const bool last = (t == nt - 2);
            const char* a1 = cA + (size_t)(t + 1) * kstep;
            const char* a2 = last ? nA : cA + (size_t)(t + 2) * kstep; const char* b2 = last ? nB : cB + (size_t)(t + 2) * kstep;
            const char* a3 = a2 + kstep; const char* b3 = b2 + kstep;
            if (last && has_next) S.a_ready(nxt);
            if constexpr (SP2) {
            PG8_LDB(B0, 0, 0); PG8_LDB(B1, 0, 1); PG8_SCHED; PG8_LDA(At, 0, 0); PG8_STAGE(PG8_SA(1, 1), a1 + hstep, voffA);
            PG8_WAIT_V(8); PG8_WAIT_L(0); PG8_BAR; PG8_MMA(0, 0, At, B0); PG8_MMA(0, 1, At, B1); PG8_BAR; PG8_SCHED;
            PG8_LDA(At, 0, 1); PG8_STAGE(PG8_SB(0, 0), b2, voffB); PG8_STAGE(PG8_SB(0, 1), b2 + hstep, voffB); PG8_STAGE(PG8_SA(0, 0), a2, voffA);
            PG8_WAIT_V(8); PG8_WAIT_L(0); PG8_BAR; PG8_MMA(1, 0, At, B0); PG8_MMA(1, 1, At, B1); PG8_BAR; PG8_SCHED;
            PG8_LDB(B0, 1, 0); PG8_LDB(B1, 1, 1); PG8_SCHED; PG8_LDA(At, 1, 0); PG8_STAGE(PG8_SA(0, 1), a2 + hstep, voffA);
            PG8_WAIT_V(8); PG8_WAIT_L(0); PG8_BAR; PG8_MMA(0, 0, At, B0); PG8_MMA(0, 1, At, B1); PG8_BAR; PG8_SCHED;
            PG8_LDA(At, 1, 1); PG8_STAGE(PG8_SB(1, 0), b3, voffB); PG8_STAGE(PG8_SB(1, 1), b3 + hstep, voffB); PG8_STAGE(PG8_SA(1, 0), a3, voffA);
            PG8_WAIT_V(8); PG8_WAIT_L(0); PG8_BAR; PG8_MMA(1, 0, At, B0); PG8_MMA(1, 1, At, B1); PG8_BAR; PG8_SCHED;
            } else {
            PG8_LDB(B0, 0, 0); PG8_SCHED; PG8_LDA(At, 0, 0); PG8_STAGE(PG8_SA(1, 1), a1 + hstep, voffA);
            PG8_WAIT_L(8); PG8_BAR; PG8_WAIT_L(0); PG8_MMA(0, 0, At, B0); PG8_BAR; PG8_SCHED;
            PG8_LDB(B1, 0, 1); PG8_STAGE(PG8_SB(0, 0), b2, voffB);
            PG8_BAR; PG8_WAIT_L(0); PG8_MMA(0, 1, At, B1); PG8_BAR;
            PG8_LDA(At, 0, 1); PG8_STAGE(PG8_SA(0, 0), a2, voffA);
            PG8_BAR; PG8_WAIT_L(0); PG8_MMA(1, 0, At, B0); PG8_BAR; PG8_SCHED;
            PG8_STAGE(PG8_SB(0, 1), b2 + hstep, voffB);
            PG8_WAIT_V(6); PG8_BAR; PG8_MMA(1, 1, At, B1); PG8_BAR;
            PG8_LDB(B0, 1, 0); PG8_SCHED; PG8_LDA(At, 1, 0); PG8_STAGE(PG8_SA(0, 1), a2 + hstep, voffA);
            PG8_WAIT_L(8); PG8_BAR; PG8_WAIT_L(0); PG8_MMA(0, 0, At, B0); PG8_BAR; PG8_SCHED;
            PG8_LDB(B1, 1, 1); PG8_STAGE(PG8_SB(1, 0), b3, voffB);
            PG8_BAR; PG8_WAIT_L(0); PG8_MMA(0, 1, At, B1); PG8_BAR;
            PG8_LDA(At, 1, 1); PG8_STAGE(PG8_SA(1, 0), a3, voffA);
            PG8_BAR; PG8_WAIT_L(0); PG8_MMA(1, 0, At, B0); PG8_BAR; PG8_SCHED;
            PG8_STAGE(PG8_SB(1, 1), b3 + hstep, voffB);
            PG8_WAIT_V(6); PG8_BAR; PG8_MMA(1, 1, At, B1); PG8_BAR;
            }
        }
        if constexpr (ALIGN_EPI) { if (wr == 0) PG8_BAR; }
        if constexpr (!Epi::AFTER_DRAIN) { E(acc, cur, wr, wc, fr, fq); S.done(cur); }
        if (!has_next) break;
#pragma unroll
        for (int a = 0; a < 2; ++a)
#pragma unroll
            for (int b = 0; b < 2; ++b)
#pragma unroll
                for (int m = 0; m < 4; ++m)
#pragma unroll
                    for (int n = 0; n < 2; ++n) acc[a][b][m][n] = (f32x4){0.f, 0.f, 0.f, 0.f};
        cur = nxt; cA = nA; cB = nB; ++ui;
        if constexpr (ALIGN_EPI) { if (wr == 1) PG8_BAR; }
    }
    PG8_WAIT_V(0);
    if constexpr (!ALIGN_EPI) { if (wr == 0) PG8_BAR; }
    PG8_BAR;
    if constexpr (Epi::AFTER_DRAIN) { E.fused(acc, cur, wr, wc, fr, fq, lds, wid, lane); S.done(cur); }
#undef PG8_SA
#undef PG8_SB
#undef PG8_STAGE
#undef PG8_LDA
#undef PG8_LDB
#undef PG8_MMA
#undef PG8_WAIT_V
#undef PG8_WAIT_L
#undef PG8_BAR
#undef PG8_SCHED
}
}

namespace attn_body {
using bf16=__hip_bfloat16;
using bf16x8=__attribute__((ext_vector_type(8)))short;
using s16x4=__attribute__((ext_vector_type(4)))short;
using f32x16=__attribute__((ext_vector_type(16)))float;
using u32x4=__attribute__((ext_vector_type(4)))unsigned;
constexpr int D=64;
constexpr int NW=8,QBLK=32,QB=QBLK*NW,KVBLK=64;
constexpr int ATTN_UNIT_ROWS=QB;
__device__ __forceinline__ int crow(int r,int hi){return (r&3)+8*(r>>2)+4*hi;}
#define SBAR() __builtin_amdgcn_sched_barrier(0)
constexpr int NSLOT=3, SLOTB=8192;
constexpr int LDS_K=0, LDS_V=NSLOT*SLOTB, LDS_WS=2*NSLOT*SLOTB, LDS_OST=LDS_WS+NW*64*4, LDS_BYTES=LDS_OST+NW*4096;
constexpr float C2=0.125f*1.4426950408889634f;
__device__ __forceinline__ void glds16(const void*gsrc,unsigned lds_dst){unsigned keep;
  asm volatile("s_mov_b32 %0, m0\n\ts_mov_b32 m0, %2\n\ts_nop 0\n\tglobal_load_lds_dwordx4 %1, off\n\ts_mov_b32 m0, %0":"=&s"(keep):"v"(gsrc),"s"(lds_dst):"memory");}
__device__ __forceinline__ float max3f(float a,float b,float c){float r;asm("v_max3_f32 %0, %1, %2, %3":"=v"(r):"v"(a),"v"(b),"v"(c));return r;}
__device__ __forceinline__ float max2f(float a,float b){float r;asm("v_max_f32_e32 %0, %1, %2":"=v"(r):"v"(a),"v"(b));return r;}
__device__ __forceinline__ float fadd_s(float a,float b){float r;asm("v_add_f32_e32 %0, %1, %2":"=v"(r):"v"(a),"v"(b));return r;}
__device__ __forceinline__ float fsub_s(float a,float b){float r;asm("v_sub_f32_e32 %0, %1, %2":"=v"(r):"v"(a),"v"(b));return r;}
typedef float f32x2_t __attribute__((ext_vector_type(2))); typedef __bf16 bf16x2_t __attribute__((ext_vector_type(2)));
__device__ __forceinline__ unsigned cvtpk_s(float lo,float hi){f32x2_t v={lo,hi};bf16x2_t b=__builtin_convertvector(v,bf16x2_t);return __builtin_bit_cast(unsigned,b);}
#define WAIT_BAR(N) asm volatile("s_waitcnt vmcnt(" #N ") lgkmcnt(0)\n\ts_barrier":::"memory")

__device__ __forceinline__ void qkt(f32x16&p0,f32x16&p1,const char*Kslot,const bf16x8*qr,const f32x16&negm,int r32,int hi){
  const int kb0=r32*128+(((r32&7)^hi)<<4);
  #pragma unroll
  for(int d0=0;d0<4;++d0){
    const bf16x8 b0=*reinterpret_cast<const bf16x8*>(Kslot+(kb0^(d0<<5)));
    const bf16x8 b1=*reinterpret_cast<const bf16x8*>(Kslot+(kb0^(d0<<5))+4096);
    if(d0==0){p0=__builtin_amdgcn_mfma_f32_32x32x16_bf16(b0,qr[0],negm,0,0,0);p1=__builtin_amdgcn_mfma_f32_32x32x16_bf16(b1,qr[0],negm,0,0,0);}
    else{p0=__builtin_amdgcn_mfma_f32_32x32x16_bf16(b0,qr[d0],p0,0,0,0);p1=__builtin_amdgcn_mfma_f32_32x32x16_bf16(b1,qr[d0],p1,0,0,0);}}
}
typedef __attribute__((address_space(3))) const char* lds_cptr;
typedef short v4i16_t __attribute__((ext_vector_type(4)));
typedef __attribute__((address_space(3))) const bf16x8* lds_k8;
__device__ __forceinline__ void kload2(bf16x8*kf,lds_cptr kslot,unsigned koff,int j){ const lds_cptr p=kslot+(koff^(unsigned)(j<<5)); kf[2*j]=*(lds_k8)p; kf[2*j+1]=*(lds_k8)(p+4096); }
__device__ __forceinline__ void kload8(bf16x8*kf,lds_cptr kslot,unsigned koff){ kload2(kf,kslot,koff,0); kload2(kf,kslot,koff,1); kload2(kf,kslot,koff,2); kload2(kf,kslot,koff,3); }
__device__ __forceinline__ s16x4 vtr(lds_cptr p){ return __builtin_bit_cast(s16x4,__builtin_amdgcn_ds_read_tr16_b64_v4i16((__attribute__((address_space(3))) v4i16_t*)p)); }
__device__ __forceinline__ float rowmax(const f32x16&p0,const f32x16&p1){
  float a=max3f(p0[0],p0[1],p1[0]),b=max3f(p0[2],p0[3],p1[1]);a=max3f(a,p1[2],p1[3]);
  #pragma unroll
  for(int r=4;r<16;r+=4){a=max3f(a,p0[r],p0[r+1]);b=max3f(b,p0[r+2],p0[r+3]);a=max3f(a,p1[r],p1[r+1]);b=max3f(b,p1[r+2],p1[r+3]);}
  const float m=max2f(a,b);
  auto rr=__builtin_amdgcn_permlane32_swap(__float_as_uint(m),__float_as_uint(m),false,false);
  return max2f(__uint_as_float(rr[0]),__uint_as_float(rr[1]));
}
__device__ __forceinline__ void pv(f32x16*o,int vb,bf16x8 pa0,bf16x8 pa1,bf16x8 pa2,bf16x8 pa3){
  #pragma unroll
  for(int d0=0;d0<2;++d0){s16x4 lo[4],hi[4];
    #pragma unroll
    for(int ks=0;ks<4;++ks){
      asm volatile("ds_read_b64_tr_b16 %0,%1 offset:%c2":"=&v"(lo[ks]):"v"(vb),"i"(d0*4096+ks*1024):"memory");
      asm volatile("ds_read_b64_tr_b16 %0,%1 offset:%c2":"=&v"(hi[ks]):"v"(vb),"i"(d0*4096+ks*1024+512):"memory");}
    asm volatile("s_waitcnt lgkmcnt(0)":::"memory");SBAR();
    #define PK(k) (bf16x8){lo[k][0],lo[k][1],lo[k][2],lo[k][3],hi[k][0],hi[k][1],hi[k][2],hi[k][3]}
    o[d0]=__builtin_amdgcn_mfma_f32_32x32x16_bf16(pa0,PK(0),o[d0],0,0,0);
    o[d0]=__builtin_amdgcn_mfma_f32_32x32x16_bf16(pa1,PK(1),o[d0],0,0,0);
    o[d0]=__builtin_amdgcn_mfma_f32_32x32x16_bf16(pa2,PK(2),o[d0],0,0,0);
    o[d0]=__builtin_amdgcn_mfma_f32_32x32x16_bf16(pa3,PK(3),o[d0],0,0,0);
    #undef PK
  }
}

#ifndef ATTN_STORE16
#define ATTN_STORE16(p,v) (*(u32x4*)(p)=(v))
#endif
template<int THRL> __device__ __forceinline__ void attn_unit(const bf16*Qu,int QP,const bf16*__restrict__ Kh,const bf16*__restrict__ Vh,int KVP,bf16*Ou,int OP,int NT,char*shm,bool dry=false){
  int tid_l=threadIdx.x; asm volatile("":"+v"(tid_l)); const int tid=tid_l,lane=tid&63,r32=lane&31,hi=lane>>5; const int wid=__builtin_amdgcn_readfirstlane(tid>>6);
  const bf16*Qw=Qu+(long)(wid*QBLK)*QP;
  const unsigned lds0=(unsigned)(uintptr_t)shm;
  float*wsf=(float*)(shm+LDS_WS)+wid*64;
  const bf16*ksrc=Kh+(long)(8*wid+(lane>>3))*KVP+(((lane&7)^((lane>>3)&7))*8);
  const bf16*vsrc=Vh+(long)(16*(wid&3)+(lane>>2))*KVP+(wid>>2)*32+(lane&3)*8;
  const unsigned kdst=lds0+LDS_K+wid*1024, vdst=lds0+LDS_V+wid*1024;
  #define DMA_K(t,slot) glds16(ksrc+(long)(t)*KVBLK*KVP,(unsigned)__builtin_amdgcn_readfirstlane(kdst+(slot)))
  #define DMA_V(t,slot) glds16(vsrc+(long)(t)*KVBLK*KVP,(unsigned)__builtin_amdgcn_readfirstlane(vdst+(slot)))
  const int vb0=(int)(lds0+LDS_V)+((lane>>4)&1)*32+(lane&3)*8+(4*hi+((lane&15)>>2))*64;
  const char*Kbase=shm+LDS_K; bf16x8 kf[8];
  const lds_cptr shm3=(lds_cptr)shm; const lds_cptr kp0=shm3+LDS_K; const unsigned koff=(unsigned)(r32*128+(((r32&7)^hi)<<4)); const lds_cptr vp0=shm3+LDS_V+((lane>>4)&1)*32+(lane&3)*8+(4*hi+((lane&15)>>2))*64;
  DMA_K(0,0);DMA_V(0,0);DMA_K(1,SLOTB);
  bf16x8 qr[4];
  #pragma unroll
  for(int d0=0;d0<4;++d0)qr[d0]=*reinterpret_cast<const bf16x8*>(&Qw[(long)r32*QP+d0*16+hi*8]);
  float mhat=0.f,l_reg=0.f;f32x16 o[2];o[0]=f32x16{};o[1]=f32x16{};f32x16 negm=f32x16{};asm volatile("":"+v"(negm));
  #define CMASK(P0,P1,t) do{}while(0)
  bool resc=false;
  #define START(P0,P1) do{ const float rm=rowmax(P0,P1); resc=false; \
    { const float dl=rm; mhat=fadd_s(mhat,dl); \
      _Pragma("unroll") for(int r=0;r<16;++r){P0[r]=fsub_s(P0[r],dl);P1[r]=fsub_s(P1[r],dl);} \
      _Pragma("unroll") for(int r=0;r<16;++r)negm[r]=-mhat; asm volatile("":"+v"(negm)); } \
    _Pragma("unroll") for(int r=0;r<16;++r)P0[r]=__builtin_amdgcn_exp2f(P0[r]); }while(0)
  #define RESC() do{ if(resc){ asm volatile("s_waitcnt lgkmcnt(0)":::"memory"); \
      _Pragma("unroll") for(int d_=0;d_<2;++d_) _Pragma("unroll") for(int r=0;r<16;++r)o[d_][r]*=wsf[crow(r,hi)]; } }while(0)
  f32x16 pA0,pA1,pB0,pB1;
  int sl_prev=0,sl_cur=0,sl_next=SLOTB;
  #define ROT() do{sl_prev=sl_cur;sl_cur=sl_next;sl_next=(sl_next==(NSLOT-1)*SLOTB)?0:sl_next+SLOTB;}while(0)
  DMA_K(2,2*SLOTB);
  WAIT_BAR(3);
  qkt(pA0,pA1,Kbase,qr,negm,r32,hi);asm volatile("s_nop 15\n\ts_nop 7":"+v"(pA0),"+v"(pA1));CMASK(pA0,pA1,0);
  START(pA0,pA1);
  _Pragma("unroll") for(int r=0;r<16;++r)pA1[r]=__builtin_amdgcn_exp2f(pA1[r]);
  WAIT_BAR(0);
  DMA_K(3,0);DMA_V(1,SLOTB);
  ROT();
  kload8(kf,kp0+sl_cur,koff);
  WAIT_BAR(2);
  s16x4 vlo[8],vhi[8]; u32x4 pw0,pw1,pw2,pw3;
  #define PKW(P,B) cvtpk_s(P[B],P[B+1])
  #define PAF(k) __builtin_bit_cast(bf16x8,pw##k)
  #define VFR(i) (bf16x8){vlo[i][0],vlo[i][1],vlo[i][2],vlo[i][3],vhi[i][0],vhi[i][1],vhi[i][2],vhi[i][3]}
  #define PIN(x) asm volatile("":"+v"(x))
  #define MX3(a,b,c) __builtin_fmaxf(__builtin_fmaxf((a),(b)),(c))
  #define GAPA(MF,A0,A1,A2,A3,W0,W1,PW) do{ MF; sacc+=A0; sacc+=A1; sacc+=A2; sacc+=A3; PIN(sacc); W0; W1; PIN(PW); SBAR(); }while(0)
  #define EX(v) __builtin_amdgcn_exp2f(v)
  #define GAPB(MF,X,B) do{ MF; X[B]=EX(X[B]); X[B+1]=EX(X[B+1]); X[B+2]=EX(X[B+2]); X[B+3]=EX(X[B+3]); PIN(X); SBAR(); }while(0)
  #define VRD(i) do{ vlo[i]=vtr(vp_+(((i)>>2)*4096+((i)&3)*1024)); vhi[i]=vtr(vp_+(((i)>>2)*4096+((i)&3)*1024+512)); }while(0)
  #define KRD(G,j) do{ if(G){ kload2(kf,kp0+sl_next,koff,j); SBAR(); } }while(0)
  #define STEP(C0,C1,P0,P1,t,GK,GV,GL) do{ SBAR(); \
    const lds_cptr vp_=vp0+sl_prev; \
    VRD(0); SBAR(); float sacc=(P0[0]+P0[1]); \
    GAPA(C0=__builtin_amdgcn_mfma_f32_32x32x16_bf16(kf[0],qr[0],negm,0,0,0), P0[2],P0[3],P0[4],P0[5],     pw0[0]=PKW(P0,0), pw0[1]=PKW(P0,2), pw0); \
    VRD(4); SBAR(); GAPA(C1=__builtin_amdgcn_mfma_f32_32x32x16_bf16(kf[1],qr[0],negm,0,0,0), P0[6],P0[7],P0[8],P0[9],     pw0[2]=PKW(P0,4), pw0[3]=PKW(P0,6), pw0); \
    VRD(1); SBAR(); GAPA(C0=__builtin_amdgcn_mfma_f32_32x32x16_bf16(kf[2],qr[1],C0,0,0,0),   P0[10],P0[11],P0[12],P0[13], pw1[0]=PKW(P0,8), pw1[1]=PKW(P0,10), pw1); \
    VRD(5); SBAR(); GAPA(C1=__builtin_amdgcn_mfma_f32_32x32x16_bf16(kf[3],qr[1],C1,0,0,0),   P0[14],P0[15],P1[0],P1[1],   pw1[2]=PKW(P0,12),pw1[3]=PKW(P0,14), pw1); \
    VRD(2); SBAR(); GAPA(C0=__builtin_amdgcn_mfma_f32_32x32x16_bf16(kf[4],qr[2],C0,0,0,0),   P1[2],P1[3],P1[4],P1[5],     pw2[0]=PKW(P1,0), pw2[1]=PKW(P1,2), pw2); \
    VRD(6); SBAR(); GAPA(C1=__builtin_amdgcn_mfma_f32_32x32x16_bf16(kf[5],qr[2],C1,0,0,0),   P1[6],P1[7],P1[8],P1[9],     pw2[2]=PKW(P1,4), pw2[3]=PKW(P1,6), pw2); \
    VRD(3); SBAR(); GAPA(C0=__builtin_amdgcn_mfma_f32_32x32x16_bf16(kf[6],qr[3],C0,0,0,0),   P1[10],P1[11],P1[12],P1[13], pw3[0]=PKW(P1,8), pw3[1]=PKW(P1,10), pw3); \
    VRD(7); SBAR(); GAPA(C1=__builtin_amdgcn_mfma_f32_32x32x16_bf16(kf[7],qr[3],C1,0,0,0),   P1[14],P1[15],0.f,0.f,       pw3[2]=PKW(P1,12),pw3[3]=PKW(P1,14), pw3); \
    l_reg+=sacc; \
    if(GK){DMA_K((t)+3,sl_cur);} if(GV){DMA_V((t)+1,sl_next);} \
    CMASK(C0,C1,t); \
    { float a=MX3(C0[0],C0[1],C1[0]),b=MX3(C0[2],C0[3],C1[1]); a=MX3(a,C1[2],C1[3]); \
      _Pragma("unroll") for(int r=4;r<16;r+=4){a=MX3(a,C0[r],C0[r+1]);b=MX3(b,C0[r+2],C0[r+3]);a=MX3(a,C1[r],C1[r+1]);b=MX3(b,C1[r+2],C1[r+3]);} \
      float rm=__builtin_fmaxf(a,b); { auto rr=__builtin_amdgcn_permlane32_swap(__float_as_uint(rm),__float_as_uint(rm),false,false); rm=__builtin_fmaxf(__uint_as_float(rr[0]),__uint_as_float(rr[1])); } \
      resc=false; \
      if(__builtin_expect(__any(rm>(float)THRL),0)){ const float dl=__builtin_fmaxf(rm,0.f); mhat+=dl; \
        _Pragma("unroll") for(int r=0;r<16;++r){C0[r]-=dl;C1[r]-=dl;} \
        _Pragma("unroll") for(int r=0;r<16;++r)negm[r]=-mhat; asm volatile("":"+v"(negm)); \
        const float f=__builtin_amdgcn_exp2f(-dl); l_reg*=f; if(hi==0)wsf[r32]=f; resc=true; } } \
    SBAR(); \
    GAPB(o[0]=__builtin_amdgcn_mfma_f32_32x32x16_bf16(PAF(0),VFR(0),o[0],0,0,0), C0,0); \
    GAPB(o[1]=__builtin_amdgcn_mfma_f32_32x32x16_bf16(PAF(0),VFR(4),o[1],0,0,0), C0,4); \
    KRD(GL,0); GAPB(o[0]=__builtin_amdgcn_mfma_f32_32x32x16_bf16(PAF(1),VFR(1),o[0],0,0,0), C0,8); \
    KRD(GL,1); GAPB(o[1]=__builtin_amdgcn_mfma_f32_32x32x16_bf16(PAF(1),VFR(5),o[1],0,0,0), C0,12); \
    KRD(GL,2); GAPB(o[0]=__builtin_amdgcn_mfma_f32_32x32x16_bf16(PAF(2),VFR(2),o[0],0,0,0), C1,0); \
    KRD(GL,3); GAPB(o[1]=__builtin_amdgcn_mfma_f32_32x32x16_bf16(PAF(2),VFR(6),o[1],0,0,0), C1,4); \
    GAPB(o[0]=__builtin_amdgcn_mfma_f32_32x32x16_bf16(PAF(3),VFR(3),o[0],0,0,0), C1,8); \
    GAPB(o[1]=__builtin_amdgcn_mfma_f32_32x32x16_bf16(PAF(3),VFR(7),o[1],0,0,0), C1,12); \
    }while(0)
  int t=1;
  for(;t+5<NT;t+=2){
    STEP(pB0,pB1,pA0,pA1,t,true,true,true);     WAIT_BAR(2); RESC(); ROT();
    STEP(pA0,pA1,pB0,pB1,t+1,true,true,true);   WAIT_BAR(2); RESC(); ROT();
  }
  #define ENDW(tt) do{ if((tt)+3<NT){WAIT_BAR(2);} else if((tt)+2<NT){WAIT_BAR(1);} else {WAIT_BAR(0);} }while(0)
  for(;t+1<NT;t+=2){
    STEP(pB0,pB1,pA0,pA1,t,(t+3<NT),(t+1<NT),(t+1<NT));       ENDW(t);   RESC(); ROT();
    STEP(pA0,pA1,pB0,pB1,t+1,(t+4<NT),(t+2<NT),(t+2<NT));     ENDW(t+1); RESC(); ROT();
  }
  STEP(pB0,pB1,pA0,pA1,NT-1,false,false,false); RESC();
  { float sacc=pB0[0]+pB0[1]; _Pragma("unroll") for(int r=2;r<16;++r)sacc+=pB0[r]; _Pragma("unroll") for(int r=0;r<16;++r)sacc+=pB1[r]; l_reg+=sacc;
    pw0=(u32x4){PKW(pB0,0),PKW(pB0,2),PKW(pB0,4),PKW(pB0,6)};pw1=(u32x4){PKW(pB0,8),PKW(pB0,10),PKW(pB0,12),PKW(pB0,14)};pw2=(u32x4){PKW(pB1,0),PKW(pB1,2),PKW(pB1,4),PKW(pB1,6)};pw3=(u32x4){PKW(pB1,8),PKW(pB1,10),PKW(pB1,12),PKW(pB1,14)};
    SBAR(); pv(o,vb0+sl_cur,PAF(0),PAF(1),PAF(2),PAF(3)); }
  #undef PKW
  #undef PAF
  #undef VFR
  #undef PIN
  #undef MX3
  #undef GAPA
  #undef GAPB
  #undef EX
  #undef VRD
  #undef KRD
  #undef STEP
  #undef ENDW
  {auto rr=__builtin_amdgcn_permlane32_swap(__float_as_uint(l_reg),__float_as_uint(l_reg),false,false);l_reg=__uint_as_float(rr[0])+__uint_as_float(rr[1]);}
  if(hi==0)wsf[32+r32]=l_reg;asm volatile("s_waitcnt lgkmcnt(0)":::"memory");
  float rli[16];
  #pragma unroll
  for(int r=0;r<16;++r)rli[r]=__builtin_amdgcn_rcpf(wsf[32+crow(r,hi)]);
  bf16*Ow=Ou+(long)(wid*QBLK)*OP;
  { bf16*stg=(bf16*)(shm+LDS_OST)+wid*2048;
    #pragma unroll
    for(int r=0;r<16;++r){const int orow=crow(r,hi);
      #pragma unroll
      for(int d0=0;d0<2;++d0)stg[orow*64+d0*32+r32]=__float2bfloat16(o[d0][r]*rli[r]);}
    asm volatile("s_waitcnt lgkmcnt(0)":::"memory");
    #pragma unroll
    for(int i=0;i<4;++i){const int row=i*8+(lane>>3),ch=lane&7; const u32x4 v=*(const u32x4*)(stg+row*64+ch*8); const u32x4 g=*(const u32x4*)(Ow+(long)row*OP+ch*8); u32x4 w;
      #pragma unroll
      for(int e=0;e<4;++e){const float lo=__uint_as_float(v[e]<<16)*__uint_as_float(g[e]<<16),hh=__uint_as_float(v[e]&0xffff0000u)*__uint_as_float(g[e]&0xffff0000u); w[e]=cvtpk_s(lo,hh);}
      ATTN_STORE16(Ow+(long)row*OP+ch*8,dry?g:w);} }
  asm volatile("s_waitcnt lgkmcnt(0)\n\ts_barrier":::"memory");
  #undef DMA_K
  #undef DMA_V
  #undef CMASK
  #undef START
  #undef RESC
  #undef ROT
}
constexpr int ATTN_LDS_BYTES=LDS_BYTES;
#undef SBAR
#undef WAIT_BAR
}

#define GAS __attribute__((address_space(1)))
#define LAS __attribute__((address_space(3)))
typedef unsigned short bf16;
typedef unsigned v4u __attribute__((ext_vector_type(4)));
typedef unsigned v2u __attribute__((ext_vector_type(2)));
typedef float f32x4 __attribute__((ext_vector_type(4)));
typedef short bf16x8 __attribute__((ext_vector_type(8)));
typedef GAS unsigned gu32;
#define RLX_AGENT __ATOMIC_RELAXED, __HIP_MEMORY_SCOPE_AGENT
#define LDS_WAIT() asm volatile("s_waitcnt lgkmcnt(0)" ::: "memory")
typedef float f32x2_t __attribute__((ext_vector_type(2))); typedef __bf16 bf16x2_t __attribute__((ext_vector_type(2)));
__device__ __forceinline__ unsigned pk2(float lo, float hi) { f32x2_t v = {lo, hi}; return __builtin_bit_cast(unsigned, __builtin_convertvector(v, bf16x2_t)); }
__device__ __forceinline__ unsigned f2bf(float f) { return pk2(f, 0.f) & 0xffffu; }
__device__ __forceinline__ float bflo(unsigned u) { return __uint_as_float(u << 16); }
__device__ __forceinline__ float bfhi(unsigned u) { return __uint_as_float(u & 0xffff0000u); }
__device__ __forceinline__ float bf1(bf16 u) { return __uint_as_float((unsigned)u << 16); }

#define XB_TMO      128
#define XB_XCNT(j)  (256  + 64 * (j))
#define XB_XSUB(j)  (1280 + 64 * (j))
#define XB_XGEN(j)  (2304 + 64 * (j))
#define XB_TOP      3328
#define XB_TOPGEN   3392
#define XCD_BAR_WORDS 3456
#define XB_SPIN_CAP (1u << 20)
__device__ __forceinline__ unsigned xb_ld(unsigned* p)              { return __hip_atomic_load(p, __ATOMIC_RELAXED, __HIP_MEMORY_SCOPE_AGENT); }
__device__ __forceinline__ unsigned xb_add(unsigned* p, unsigned v) { return __hip_atomic_fetch_add(p, v, __ATOMIC_RELAXED, __HIP_MEMORY_SCOPE_AGENT); }
__device__ __forceinline__ unsigned xb_xcc_id() { return (unsigned)__builtin_amdgcn_s_getreg((3 << 11) | 20) & 0xFu; }
#define XB_SPIN(cond, bar) do { unsigned _sp = 0; while (cond) { __builtin_amdgcn_s_sleep(1); \
    if ((++_sp & 255u) == 0u) { if (xb_ld(&(bar)[XB_TMO])) break; if (_sp > XB_SPIN_CAP) { atomicAdd(&(bar)[XB_TMO], 1u); break; } } } } while (0)
struct XcdBarrier { unsigned* bar; unsigned x; volatile LAS unsigned* st; };
__device__ __forceinline__ XcdBarrier xcd_barrier_post(unsigned* bar, volatile LAS unsigned* st) {
    XcdBarrier b; b.bar = bar; b.x = xb_xcc_id(); b.st = st;
    if (threadIdx.x == 0) (void)xb_add(&bar[XB_XCNT(b.x)], 1u);
    return b;
}
__device__ __forceinline__ void xcd_barrier_complete(unsigned* bar, unsigned x, unsigned& nloc, unsigned& nx) {
    const unsigned G = gridDim.x * gridDim.y * gridDim.z;
    unsigned sum, cnt, mine, sp = 0u;
    for (;;) {
        sum = 0u; cnt = 0u; mine = 0u;
#pragma unroll
        for (unsigned j = 0; j < 16; ++j) { const unsigned c = xb_ld(&bar[XB_XCNT(j)]); sum += c; cnt += (c > 0u) ? 1u : 0u; mine = (j == x) ? c : mine; }
        if (sum == G) break;
        __builtin_amdgcn_s_sleep(1);
        if ((++sp & 255u) == 0u) { if (xb_ld(&bar[XB_TMO])) break; if (sp > XB_SPIN_CAP) { atomicAdd(&bar[XB_TMO], 1u); break; } }
    }
    nloc = mine > 0u ? mine : 1u; nx = cnt > 0u ? cnt : 1u;
}
__device__ __forceinline__ void xcd_barrier(const XcdBarrier& b) {
    asm volatile("s_waitcnt vmcnt(0)" ::: "memory");
    __syncthreads();
    if (threadIdx.x == 0) {
        unsigned* bar = b.bar; unsigned bx = b.x; asm volatile("" : "+s"(bx));
        __builtin_amdgcn_s_waitcnt(0);
        unsigned nloc = b.st[0], nx = b.st[1];
        if (nloc == 0u) { xcd_barrier_complete(bar, bx, nloc, nx); b.st[0] = nloc; b.st[1] = nx; }
        const unsigned old = xb_add(&bar[XB_XSUB(bx)], 1u);
        const unsigned gen = old / nloc;
        if (old + 1u == (gen + 1u) * nloc) {
            __builtin_amdgcn_fence(__ATOMIC_RELEASE, "agent");
            asm volatile("s_waitcnt vmcnt(0)" ::: "memory");
            const unsigned og = xb_add(&bar[XB_TOP], 1u);
            const unsigned tg = og / nx;
            if (og + 1u == (tg + 1u) * nx) xb_add(&bar[XB_TOPGEN], 1u);
            else XB_SPIN(xb_ld(&bar[XB_TOPGEN]) == tg, bar);
            __builtin_amdgcn_fence(__ATOMIC_ACQUIRE, "agent");
            asm volatile("s_waitcnt vmcnt(0)" ::: "memory");
        } else {
            XB_SPIN(xb_ld(&bar[XB_TOPGEN]) == gen, bar);
            __builtin_amdgcn_fence(__ATOMIC_ACQUIRE, "agent");
            asm volatile("s_waitcnt vmcnt(0)" ::: "memory");
        }
    }
    __syncthreads();
}

#define XB_S_CNT(k, j) (4096 + 1024 * (k) + 64 * (j))
#define XB_S_TOP(k)    (4096 + 1024 * (k) + 992)
__device__ __forceinline__ void xcd_arrive(const XcdBarrier& b, int k) {
    asm volatile("s_waitcnt vmcnt(0)" ::: "memory");
    __syncthreads();
    if (threadIdx.x == 0) {
        unsigned* bar = b.bar; const unsigned nloc = b.st[0]; unsigned bx = b.x; asm volatile("" : "+s"(bx));
        const unsigned old = xb_add(&bar[XB_S_CNT(k, bx)], 1u);
        if (old + 1u == nloc) {
            __builtin_amdgcn_fence(__ATOMIC_RELEASE, "agent");
            asm volatile("s_waitcnt vmcnt(0)" ::: "memory");
            xb_add(&bar[XB_S_TOP(k)], 1u);
        }
    }
}
__device__ __forceinline__ void xcd_wait(const XcdBarrier& b, int k) {
    if (threadIdx.x == 0) {
        unsigned* bar = b.bar; const unsigned nx = b.st[1];
        XB_SPIN(xb_ld(&bar[XB_S_TOP(k)]) != nx, bar);
        __builtin_amdgcn_fence(__ATOMIC_ACQUIRE, "agent");
        asm volatile("s_waitcnt vmcnt(0)" ::: "memory");
    }
    __syncthreads();
}

struct Args { const float* in[21]; float* out; unsigned char* ws; };

__device__ __forceinline__ float wave_sum(float v) {
    v += __int_as_float(__builtin_amdgcn_update_dpp(0, __float_as_int(v), 0xB1, 0xF, 0xF, true));
    v += __int_as_float(__builtin_amdgcn_update_dpp(0, __float_as_int(v), 0x4E, 0xF, 0xF, true));
    v += __int_as_float(__builtin_amdgcn_update_dpp(0, __float_as_int(v), 0x141, 0xF, 0xF, true));
    v += __int_as_float(__builtin_amdgcn_update_dpp(0, __float_as_int(v), 0x140, 0xF, 0xF, true));
    const int b = __float_as_int(v);
    return (__int_as_float(__builtin_amdgcn_readlane(b, 0)) + __int_as_float(__builtin_amdgcn_readlane(b, 16))) + (__int_as_float(__builtin_amdgcn_readlane(b, 32)) + __int_as_float(__builtin_amdgcn_readlane(b, 48)));
}
__device__ __forceinline__ float fsilu(float x) { return x * __builtin_amdgcn_rcpf(1.0f + __builtin_amdgcn_exp2f(-1.4426950408889634f * x)); }
__device__ __forceinline__ f32x4 mfma16(bf16x8 a, bf16x8 b, f32x4 c) { return __builtin_amdgcn_mfma_f32_16x16x32_bf16(a, b, c, 0, 0, 0); }

__device__ __forceinline__ void* ldptr(volatile LAS unsigned* M, int w) {
    unsigned base = (unsigned)(uintptr_t)M; asm volatile("" : "+v"(base));
    volatile LAS unsigned* p = (volatile LAS unsigned*)(uintptr_t)base;
    const unsigned lo = __builtin_amdgcn_readfirstlane(p[w]), hi = __builtin_amdgcn_readfirstlane(p[w + 1]); return (void*)(GAS void*)(((unsigned long long)hi << 32) | (unsigned long long)lo); }
__device__ __forceinline__ void p0_transpose_item(const float* W, int Nsrc, int nsrc0, bf16* WT, int K, int drow0, LAS float* scr, int k0, int lane) {
    float x[32];
#pragma unroll
    for (int i = 0; i < 32; ++i) { const int kk = 2 * i + (lane >> 5); x[i] = W[(size_t)(k0 + kk) * Nsrc + nsrc0 + (lane & 31)]; }
#pragma unroll
    for (int i = 0; i < 32; ++i) { const int kk = 2 * i + (lane >> 5); scr[kk * 33 + (lane & 31)] = x[i]; }
    LDS_WAIT(); asm volatile("" ::: "memory");
    const int c = lane & 7;
#pragma unroll
    for (int j = 0; j < 4; ++j) { const int n = (lane >> 3) + 8 * j; const LAS float* s = scr + (8 * c) * 33 + n;
        v4u o; o.x = pk2(s[0 * 33], s[1 * 33]); o.y = pk2(s[2 * 33], s[3 * 33]); o.z = pk2(s[4 * 33], s[5 * 33]); o.w = pk2(s[6 * 33], s[7 * 33]);
        *(GAS v4u*)(WT + (size_t)(drow0 + n) * K + k0 + 8 * c) = o; }
    LDS_WAIT(); asm volatile("" ::: "memory");
}

#define INP(i) ((const float*)ldptr(MISC, 32 + 2 * (i)))
#define OUTP ((float*)ldptr(MISC, 32 + 42))
#define WSP ((unsigned char*)ldptr(MISC, 32 + 44))
template <int PD_R> __device__ __forceinline__ void pd_rows(volatile LAS unsigned* MISC, const int l, const int rbeg, const int rend, const int wrank, const int nwr, const int lane) {
    unsigned char* ws = WSP; float* out = OUTP; const float* x_prompt = INP(0); const float* x_sample = INP(1); const float* norm_pre = INP(9); const float* norm_post = INP(10);
    const float* modv = (const float*)(ws + WS_MOD); const float* SS = (const float*)(ws + WS_SS); const bf16* Yb = (const bf16*)(ws + WS_Z); bf16* Hb = (bf16*)(ws + WS_H);
    for (int row0 = rbeg + PD_R * wrank; row0 < rend; row0 += PD_R * nwr) {
        const int ci = row0 < NPR ? 0 : 1 + ((row0 - NPR) >> 12);
        const float* src = (l == 2) ? out + (size_t)row0 * DMOD : (row0 < NPR ? x_prompt + (size_t)row0 * DMOD : x_sample + (size_t)(row0 - NPR) * DMOD);
        f32x4 v[PD_R][4];
#pragma unroll
        for (int r = 0; r < PD_R; ++r)
#pragma unroll
            for (int j = 0; j < 4; ++j) v[r][j] = __builtin_nontemporal_load((const f32x4*)(src + (size_t)r * DMOD + 4 * lane + 256 * j));
        if (l > 0) {
            v2u yy[PD_R][4]; float ssp[PD_R];
#pragma unroll
            for (int r = 0; r < PD_R; ++r) { ssp[r] = lane < 16 ? SS[(size_t)(row0 + r) * 16 + lane] : 0.f;
#pragma unroll
                for (int j = 0; j < 4; ++j) yy[r][j] = __builtin_nontemporal_load((const v2u*)(Yb + (size_t)(row0 + r) * 1024 + 4 * lane + 256 * j)); }
            const float* gp = modv + (size_t)((l - 1) * 5 + ci) * 3072 + 2048; const float* np = norm_post + (l - 1) * 1024;
            asm volatile("" : "+s"(np));
            float rinv[PD_R];
#pragma unroll
            for (int r = 0; r < PD_R; ++r) rinv[r] = __int_as_float(__builtin_amdgcn_readfirstlane(__float_as_int(rsqrtf(wave_sum(ssp[r]) * (1.0f / 1024.0f) + EPS))));
#pragma unroll
            for (int j = 0; j < 4; ++j) { const int col = 4 * lane + 256 * j; const f32x4 g4 = *(const f32x4*)(gp + col), n4 = *(const f32x4*)(np + col);
#pragma unroll
                for (int r = 0; r < PD_R; ++r) { const v2u y2 = yy[r][j];
                    v[r][j][0] += g4[0] * (bflo(y2.x) * rinv[r] * n4[0]); v[r][j][1] += g4[1] * (bfhi(y2.x) * rinv[r] * n4[1]);
                    v[r][j][2] += g4[2] * (bflo(y2.y) * rinv[r] * n4[2]); v[r][j][3] += g4[3] * (bfhi(y2.y) * rinv[r] * n4[3]);
                    __builtin_nontemporal_store(v[r][j], (f32x4*)(out + (size_t)(row0 + r) * DMOD + col)); } }
        }
        if (l < 2) {
            float rinv2[PD_R];
#pragma unroll
            for (int r = 0; r < PD_R; ++r) { float s2 = 0.f;
#pragma unroll
                for (int j = 0; j < 4; ++j) s2 += (v[r][j][0] * v[r][j][0] + v[r][j][1] * v[r][j][1]) + (v[r][j][2] * v[r][j][2] + v[r][j][3] * v[r][j][3]);
                rinv2[r] = __int_as_float(__builtin_amdgcn_readfirstlane(__float_as_int(rsqrtf(wave_sum(s2) * (1.0f / 1024.0f) + EPS)))); }
            const float* mp = modv + (size_t)(l * 5 + ci) * 3072; const float* np = norm_pre + l * 1024;
            asm volatile("" : "+s"(np));
#pragma unroll
            for (int j = 0; j < 4; ++j) { const int col = 4 * lane + 256 * j;
                const f32x4 sh = *(const f32x4*)(mp + col), scl = *(const f32x4*)(mp + 1024 + col), n4 = *(const f32x4*)(np + col);
#pragma unroll
                for (int r = 0; r < PD_R; ++r) { f32x4 h;
#pragma unroll
                    for (int e = 0; e < 4; ++e) h[e] = v[r][j][e] * rinv2[r] * n4[e] * (1.0f + scl[e]) + sh[e];
                    v2u o; o.x = pk2(h[0], h[1]); o.y = pk2(h[2], h[3]);
                    *(v2u*)(Hb + (size_t)(row0 + r) * 1024 + col) = o; } }
        }
    }
}

__device__ __forceinline__ void ctx_rows(volatile LAS unsigned* MISC, const int l, const int gt, const int NGT) {
    unsigned char* ws = WSP; const float* cache_k = INP(2); const float* cache_v = INP(3); bf16* KSb = (bf16*)(ws + WS_KS); bf16* VSb = (bf16*)(ws + WS_VS);
    for (int idx = gt; idx < 2 * 32768; idx += NGT) { const int kv = idx >> 15, r = idx & 32767, b = r >> 13, j = (r >> 5) & 255, c4 = (r & 31) * 4;
        const float* sp = (kv ? cache_v : cache_k) + ((size_t)((b * 2 + l) * 256 + j)) * 128 + c4;
        const f32x4 x = *(const f32x4*)sp; v2u o; o.x = pk2(x[0], x[1]); o.y = pk2(x[2], x[3]);
        *(v2u*)((kv ? VSb : KSb) + ((size_t)b * 4352 + 4096 + j) * 128 + c4) = o; }
}

constexpr int DN_TS = 144;
constexpr int DN_TKN = 0, DN_TQN = 9216, DN_TKT = 18432, DN_TVN = 27648, DN_DIRB = 36864, DN_DIRSZ = 57600;
constexpr int DN_LF = 0, DN_WT = 17408, DN_WDT = 26624, DN_UT = 35840, DN_UDT = 45056, DN_SC = 54272, DN_TI = 55552;
constexpr int DN_TAPS = DN_DIRB + 2 * DN_DIRSZ;
static_assert(DN_TAPS + 3072 <= RING_BYTES, "DeltaNet LDS map");
typedef short s16x4 __attribute__((ext_vector_type(4)));
__device__ __forceinline__ f32x4 mfma16k16(s16x4 a, s16x4 b, f32x4 c) { return __builtin_amdgcn_mfma_f32_16x16x16bf16_1k(a, b, c, 0, 0, 0); }
#define DN_LAUNDER(x_) asm volatile("" : "+v"(x_))
template <int DIR> __device__ __forceinline__ void dn_inv16(LAS unsigned char* db, int lane) {
    const int b = lane >> 4, c = lane & 15; float t[16];
    unsigned lb = (unsigned)(uintptr_t)(db + DN_LF) + (DIR == 0 ? (16 * b) * 276 : (48 - 16 * b) * 276); DN_LAUNDER(lb);
#pragma unroll
    for (int r = 0; r < 16; ++r) { float s = (r == c) ? 1.f : 0.f;
#pragma unroll
        for (int q = 0; q < 4; ++q) if (4 * q < r) { f32x4 Lr;
            if (DIR == 0) Lr = *(const LAS f32x4*)(uintptr_t)(lb + r * 272 + q * 16);
            else { const f32x4 y = *(const LAS f32x4*)(uintptr_t)(lb + (15 - r) * 272 + (12 - 4 * q) * 4); Lr = (f32x4){y[3], y[2], y[1], y[0]}; }
#pragma unroll
            for (int e = 0; e < 4; ++e) if (4 * q + e < r) s -= Lr[e] * t[4 * q + e]; }
        t[r] = s; }
    unsigned tb = (unsigned)(uintptr_t)(db + DN_TI) + b * 512 + c * 2; DN_LAUNDER(tb);
#pragma unroll
    for (int r = 0; r < 16; ++r) *(LAS bf16*)(uintptr_t)(tb + r * 32) = (bf16)f2bf(t[r]);
}
template <int DIR> __device__ __forceinline__ void dn_subst(LAS unsigned char* lds, LAS unsigned char* db, int gwv, int lane) {
    const int fr = lane & 15, fq = lane >> 4; const bool isw = gwv >= 2;
    s16x4 ti[4], al[6];
    unsigned tb = (unsigned)(uintptr_t)(db + DN_TI) + fr * 32 + fq * 8; DN_LAUNDER(tb);
#pragma unroll
    for (int bi = 0; bi < 4; ++bi) ti[bi] = *(const LAS s16x4*)(uintptr_t)(tb + bi * 512);
    unsigned lb = (unsigned)(uintptr_t)(db + DN_LF) + (DIR == 0 ? fr * 272 + fq * 16 : (15 - fr) * 272 + (12 - 4 * fq) * 4); DN_LAUNDER(lb);
#pragma unroll
    for (int bi = 1; bi < 4; ++bi)
#pragma unroll
        for (int bj = 0; bj < 3; ++bj) if (bj < bi) { f32x4 x;
            if (DIR == 0) x = *(const LAS f32x4*)(uintptr_t)(lb + (16 * bi) * 272 + (16 * bj) * 4);
            else { const f32x4 y = *(const LAS f32x4*)(uintptr_t)(lb + (48 - 16 * bi) * 272 + (48 - 16 * bj) * 4); x = (f32x4){y[3], y[2], y[1], y[0]}; }
            v2u pk; pk.x = pk2(-x[0], -x[1]); pk.y = pk2(-x[2], -x[3]); al[bi * (bi - 1) / 2 + bj] = __builtin_bit_cast(s16x4, pk); }
    unsigned sb = (unsigned)(uintptr_t)(db + DN_SC) + (DIR == 0 ? 4 * fq : 12 - 4 * fq) * 4; DN_LAUNDER(sb);
    const int cc0 = 32 * (gwv & 1) + fr;
    unsigned xb = (unsigned)(uintptr_t)(lds + (isw ? DN_TKN : DN_TVN)) + cc0 * 2 + (DIR == 0 ? 4 * fq : 12 - 4 * fq) * DN_TS; DN_LAUNDER(xb);
    unsigned rb = (unsigned)(uintptr_t)(db + (isw ? DN_WT : DN_UT)) + cc0 * DN_TS + (DIR == 0 ? 4 * fq : 12 - 4 * fq) * 2; DN_LAUNDER(rb);
    f32x4 S[2][4], ed[2][4];
#pragma unroll
    for (int tt = 0; tt < 2; ++tt) {
#pragma unroll
        for (int bi = 0; bi < 4; ++bi) { const int po = (DIR == 0 ? 16 * bi : 48 - 16 * bi);
            f32x4 be = *(const LAS f32x4*)(uintptr_t)(sb + po * 4), eg = *(const LAS f32x4*)(uintptr_t)(sb + 512 + po * 4), dd = *(const LAS f32x4*)(uintptr_t)(sb + 768 + po * 4);
            f32x4 xv;
#pragma unroll
            for (int e = 0; e < 4; ++e) xv[e] = bf1(*(const LAS bf16*)(uintptr_t)(xb + tt * 32 + (po + e) * DN_TS));
            f32x4 sv;
#pragma unroll
            for (int e = 0; e < 4; ++e) sv[e] = be[e] * (isw ? eg[e] * xv[e] : xv[e]);
            if (DIR == 0) { S[tt][bi] = sv; ed[tt][bi] = dd; } else { S[tt][bi] = (f32x4){sv[3], sv[2], sv[1], sv[0]}; ed[tt][bi] = (f32x4){dd[3], dd[2], dd[1], dd[0]}; } }
    }
#define DN_CVT(v_) __builtin_bit_cast(s16x4, (v2u){pk2((v_)[0], (v_)[1]), pk2((v_)[2], (v_)[3])})
    const f32x4 zz = (f32x4){0.f, 0.f, 0.f, 0.f}; f32x4 X[2][4]; s16x4 xb0[2], xb1[2], xb2[2];
#define DN_BOTH(stmt_) do { { constexpr int tt = 0; stmt_; } { constexpr int tt = 1; stmt_; } } while (0)
    DN_BOTH(X[tt][0] = mfma16k16(ti[0], DN_CVT(S[tt][0]), zz));
    DN_BOTH(xb0[tt] = DN_CVT(X[tt][0]));
    DN_BOTH(S[tt][1] = mfma16k16(al[0], xb0[tt], S[tt][1]));
    DN_BOTH(S[tt][2] = mfma16k16(al[1], xb0[tt], S[tt][2]));
    DN_BOTH(S[tt][3] = mfma16k16(al[3], xb0[tt], S[tt][3]));
    DN_BOTH(X[tt][1] = mfma16k16(ti[1], DN_CVT(S[tt][1]), zz));
    DN_BOTH(xb1[tt] = DN_CVT(X[tt][1]));
    DN_BOTH(S[tt][2] = mfma16k16(al[2], xb1[tt], S[tt][2]));
    DN_BOTH(S[tt][3] = mfma16k16(al[4], xb1[tt], S[tt][3]));
    DN_BOTH(X[tt][2] = mfma16k16(ti[2], DN_CVT(S[tt][2]), zz));
    DN_BOTH(xb2[tt] = DN_CVT(X[tt][2]));
    DN_BOTH(S[tt][3] = mfma16k16(al[5], xb2[tt], S[tt][3]));
    DN_BOTH(X[tt][3] = mfma16k16(ti[3], DN_CVT(S[tt][3]), zz));
#undef DN_BOTH
#undef DN_CVT
#pragma unroll
    for (int tt = 0; tt < 2; ++tt)
#pragma unroll
        for (int bi = 0; bi < 4; ++bi) { const f32x4 x = X[tt][bi]; const f32x4 xd = x * ed[tt][bi]; const int po = (DIR == 0 ? 16 * bi : 48 - 16 * bi); v2u o, od;
            if (DIR == 0) { o.x = pk2(x[0], x[1]); o.y = pk2(x[2], x[3]); od.x = pk2(xd[0], xd[1]); od.y = pk2(xd[2], xd[3]); }
            else { o.x = pk2(x[3], x[2]); o.y = pk2(x[1], x[0]); od.x = pk2(xd[3], xd[2]); od.y = pk2(xd[1], xd[0]); }
            *(LAS v2u*)(uintptr_t)(rb + tt * 16 * DN_TS + po * 2) = o; *(LAS v2u*)(uintptr_t)(rb + 9216 + tt * 16 * DN_TS + po * 2) = od; }
}

__device__ __forceinline__ void stage_layer_tables(volatile LAS unsigned* MISC, LAS unsigned char* lds, const int l, const int tid, const int vcu) {
    unsigned char* ws = WSP; const float* conv_w = INP(17);
    LAS float* tabw = (LAS float*)(lds + pg8::STAGE_BYTES); const float* rope = (const float*)(ws + WS_ROPE); const float* qn = INP(15) + l * 64; const float* kn = INP(16) + l * 64;
    for (int i = tid; i < 2048; i += NWAVES * 64) tabw[i] = rope[i];
    if (tid < 64) tabw[2048 + tid] = qn[tid]; else if (tid < 128) tabw[2048 + tid] = kn[tid - 64];
    else if (tid < 136) tabw[2176 + tid - 128] = INP(18)[l * 8 + tid - 128]; else if (tid < 144) tabw[2184 + tid - 136] = INP(19)[l * 8 + tid - 136];
    const bool isA = (vcu & 31) < 16; const int h0 = ((isA ? 0 : 640) + (vcu >> 5) * 16 + (vcu & 15)) & 3;
    for (int i = tid; i < 768; i += NWAVES * 64) { const int j = i / 192, rest = i - 192 * j, sg = rest >> 6, c = rest & 63;
        ((LAS float*)(lds + DN_TAPS))[(j * 3 + sg) * 64 + c] = conv_w[(size_t)l * 3072 + j * 768 + sg * 256 + h0 * 64 + c]; }
}


__global__ void __launch_bounds__(NWAVES * 64, 2) mk_fwd(Args args) {
    extern __shared__ __attribute__((aligned(16))) unsigned char lds_raw[];
    LAS unsigned char* lds = (LAS unsigned char*)lds_raw;
    volatile LAS unsigned* MISC = (volatile LAS unsigned*)(lds + MISC_OFF);
    const int tid0 = threadIdx.x;
    const int G = gridDim.x, bid = blockIdx.x;
    const int vcu0 = (G % 8 == 0) ? (bid % 8) * (G / 8) + bid / 8 : bid;
#define PHASE_LOCALS() int tid = tid0, vcu = vcu0; asm volatile("" : "+v"(tid), "+s"(vcu)); \
    const int lane = tid & 63, wave = __builtin_amdgcn_readfirstlane(tid >> 6), fr = lane & 15, fq = lane >> 4, gw = vcu * NWAVES + wave, NGW = G * NWAVES; \
    (void)fr; (void)fq; (void)gw; (void)NGW; (void)lane; (void)wave
    for (int u = tid0; u < (LDS_BYTES - MISC_OFF) / 4; u += NWAVES * 64) ((LAS unsigned*)(lds + MISC_OFF))[u] = 0u;
    __syncthreads();
    if (tid0 < 46) ((LAS unsigned*)(lds + MISC_OFF))[32 + tid0] = ((const unsigned*)&args)[tid0];
    __syncthreads();
    if (tid0 < 64) __hip_atomic_store((unsigned*)(WSP + WS_CTL) + bid * 64 + tid0, 0u, __ATOMIC_RELAXED, __HIP_MEMORY_SCOPE_AGENT);
    cg::grid_group grid = cg::this_grid();

#ifndef SKIP_P0
    asm volatile("; MARK_P0" ::: "memory");
    { PHASE_LOCALS();
    {
        unsigned char* ws = WSP; const float* w_in = INP(11); const float* w_out = INP(12); const float* pool_w = INP(13);
        bf16* Wt_in = (bf16*)(ws + WS_WIN); bf16* Wt_out = (bf16*)(ws + WS_WOUT); bf16* poolT = (bf16*)(ws + WS_POOLW); float* modv = (float*)(ws + WS_MOD); float* rope = (float*)(ws + WS_ROPE);
        const int gt = vcu * (NWAVES * 64) + tid, NGT = G * NWAVES * 64;
        for (int idx = gt; idx < 2 * 4 * 64 * 64; idx += NGT) { const int lg = idx >> 12, d = (idx >> 6) & 63, c = idx & 63; poolT[idx] = (bf16)f2bf(pool_w[(size_t)lg * 4096 + c * 64 + d]); }
        if (bid == G - 1) {
            for (int idx = tid; idx < 1024; idx += NWAVES * 64) { const int pos = idx >> 4, i = idx & 15;
                const float inv = exp2f(-(float)(2 * i) * (1.0f / 32.0f) * 13.287712379549449f); const float ang = (float)pos * inv;
                rope[idx] = cosf(ang); rope[1024 + idx] = sinf(ang); }
        }
        __syncthreads();
        const float* cvec = INP(5); const float* cctx = INP(6); const float* w_mod = INP(7); const float* b_mod = INP(8);
        if (bid < 192) {
            LAS float* sc = (LAS float*)lds;
            LAS float* red = (LAS float*)(lds + 20480);
            for (int idx = tid; idx < 5 * 1024; idx += NWAVES * 64) { const int ci = idx >> 10, k = idx & 1023; const float cv = ci == 0 ? cctx[k] : cvec[(ci - 1) * 1024 + k]; sc[idx] = fsilu(cv); }
            __syncthreads();
            const int l = bid / 96, col = (bid % 96) * 32 + (lane & 31), kh = lane >> 5;
            const float* wp = w_mod + (size_t)l * 1024 * 3072 + (size_t)(wave * 128 + kh) * 3072 + col;
            float a0 = 0.f, a1 = 0.f, a2 = 0.f, a3 = 0.f, a4 = 0.f;
            float wvs[64];
#pragma unroll
            for (int i = 0; i < 64; ++i) wvs[i] = wp[(size_t)(2 * i) * 3072];
#pragma unroll
            for (int i = 0; i < 64; ++i) { const float wv = wvs[i]; const int kk = wave * 128 + 2 * i + kh;
                a0 += sc[kk] * wv; a1 += sc[1024 + kk] * wv; a2 += sc[2048 + kk] * wv; a3 += sc[3072 + kk] * wv; a4 += sc[4096 + kk] * wv; }
            a0 += __shfl_xor(a0, 32); a1 += __shfl_xor(a1, 32); a2 += __shfl_xor(a2, 32); a3 += __shfl_xor(a3, 32); a4 += __shfl_xor(a4, 32);
            if (lane < 32) { red[(wave * 5 + 0) * 32 + lane] = a0; red[(wave * 5 + 1) * 32 + lane] = a1; red[(wave * 5 + 2) * 32 + lane] = a2; red[(wave * 5 + 3) * 32 + lane] = a3; red[(wave * 5 + 4) * 32 + lane] = a4; }
            __syncthreads();
            if (tid < 160) { const int ci = tid >> 5, c = tid & 31; float s = b_mod[l * 3072 + (bid % 96) * 32 + c];
#pragma unroll
                for (int w = 0; w < 8; ++w) s += red[(w * 5 + ci) * 32 + c];
                modv[(size_t)(l * 5 + ci) * 3072 + (bid % 96) * 32 + c] = s; }
            __syncthreads();
        }
    }
    }
#endif
    grid.sync();
    XcdBarrier bar = xcd_barrier_post((unsigned*)(WSP + WS_CTL) + CW_BAR, MISC + 8);
#define GRID_BAR() xcd_barrier(bar)

#ifndef SKIP_PD
    asm volatile("; MARK_PD" ::: "memory");
    { PHASE_LOCALS();
        {
        unsigned char* ws = WSP; const float* w_in = INP(11); const float* w_out = INP(12);
        bf16* Wt_in = (bf16*)(ws + WS_WIN); bf16* Wt_out = (bf16*)(ws + WS_WOUT);
        LAS float* scr = (LAS float*)(lds + wave * 16384);
        constexpr int I_IN = 16 * 88, I_OUT = 16 * 32;
        if (wave >= 6)
        for (int it = vcu * 2 + (wave - 6); it < 2 * I_IN + 2 * I_OUT; it += 2 * G) {
            if (it < 2 * I_IN) {
                const int l = it / I_IN, r = it % I_IN, kb = r / 88, nb = r % 88, tile = nb >> 3, g8 = nb & 7;
                const int nlog = tile * 256 + 64 * (g8 & 3) + 32 * (g8 >> 2), nsrc = nlog < 2560 ? nlog : nlog + 16;
                p0_transpose_item(w_in + (size_t)l * 1024 * 2832, 2832, nsrc, Wt_in + (size_t)l * NIN * 1024, 1024, tile * 256 + 32 * g8, scr, 64 * kb, lane);
            } else {
                const int r2 = it - 2 * I_IN, l = r2 / I_OUT, r = r2 % I_OUT, kb = r / 32, nb = r % 32;
                p0_transpose_item(w_out + (size_t)l * 1024 * 1024, 1024, 32 * nb, Wt_out + (size_t)l * 1024 * 1024, 1024, 32 * nb, scr, 64 * kb, lane);
            }
        }
        const int gt = vcu * (NWAVES * 64) + tid, NGT = G * NWAVES * 64;
        for (int idx = gt; idx < 2 * 256 * 1024; idx += NGT) { const int l = idx >> 18, r = (idx >> 10) & 255, k = idx & 1023;
            const float v = r < 16 ? w_in[(size_t)l * 1024 * 2832 + (size_t)k * 2832 + 2560 + r] : 0.f;
            Wt_in[(size_t)l * NIN * 1024 + (size_t)(2816 + r) * 1024 + k] = (bf16)f2bf(v); }
        }
        stage_layer_tables(MISC, lds, 0, tid, vcu);
        if (wave < 6) pd_rows<4>(MISC, 0, 0, NTOK, vcu * 6 + wave, G * 6, lane);
        ctx_rows(MISC, 0, vcu * (NWAVES * 64) + tid, G * NWAVES * 64);
    }
#endif
    GRID_BAR();
    for (int l = 0; l < 2; ++l) {
#ifndef SKIP_PA
    asm volatile("; MARK_PA" ::: "memory");
    { PHASE_LOCALS();
        {
            unsigned char* ws = WSP; float* out = OUTP;
            bf16* Hb = (bf16*)(ws + WS_H); bf16* Wt_in = (bf16*)(ws + WS_WIN);
            pg8::Gemm g{Hb, Wt_in + (size_t)l * NIN * 1024, NTOK, NIN, 1024};
            pg8::EpiIn E{ws, out + OUT_K + (size_t)l * 256 * 128, out + OUT_V + (size_t)l * 256 * 128,
                         (const LAS float*)(lds + pg8::STAGE_BYTES), 0};
            const int x = bid & 7, j = bid >> 3;
#pragma nounroll
            for (int c = 0; c < 2; ++c) {
                if (c == 1 && j >= 16) { xcd_arrive(bar, 4 + 2 * l + c); break; }
                pg8::PaOrder S; S.x = x; S.j = j; S.r0 = 4 * c; S.nr = c == 0 ? 4 : 1;
                pg8::gemm_phase<pg8::EpiIn, pg8::PaOrder, true, true>(lds, g, S, E);
                xcd_arrive(bar, 4 + 2 * l + c);
            }
        }
    }
#endif
#ifndef SKIP_PB1
        asm volatile("; MARK_SKIP_PB1" ::: "memory");
        { PHASE_LOCALS();
        {
#ifdef PROBE_PB1
            const bool dry = (rep_ == 0);
#else
            const bool dry = false;
#endif
            unsigned char* ws = WSP; bf16* X2 = (bf16*)(ws + WS_X2);
            xcd_wait(bar, 4 + 2 * l);
            const bf16* Qb = (const bf16*)(ws + WS_Q); const bf16* KPb = (const bf16*)(ws + WS_KP); const bf16* VPb = (const bf16*)(ws + WS_VP); const bf16* KSb = (const bf16*)(ws + WS_KS); const bf16* VSb = (const bf16*)(ws + WS_VS);
            for (int k = vcu; k < 512; k += G) {
                const int su = ((k & 255) >> 5) * 64 + (k & 31) + 32 * (k >> 8);
                const int xg = su >> 6, b = xg >> 1, kvh = xg & 1, h = kvh * 4 + ((su & 63) >> 4), qb = su & 15;
                const size_t r0 = (size_t)NPR + (size_t)b * 4096 + (size_t)qb * 256;
                attn_body::attn_unit<8>((const attn_body::bf16*)(Qb + r0 * 512 + h * 64), 512, (const attn_body::bf16*)(KSb + (size_t)b * 4352 * 128 + kvh * 64), (const attn_body::bf16*)(VSb + (size_t)b * 4352 * 128 + kvh * 64), 128,
                                        (attn_body::bf16*)(X2 + r0 * 1024 + 256 + h * 64), 1024, 68, (char*)lds_raw, dry);
            }
            for (int k = vcu; k < 256; k += G) {
                const int b = k >> 3, h = k & 7; const size_t r0 = (size_t)b * 256;
                attn_body::attn_unit<8>((const attn_body::bf16*)(Qb + r0 * 512 + h * 64), 512, (const attn_body::bf16*)(KPb + r0 * 128 + (h >> 2) * 64), (const attn_body::bf16*)(VPb + r0 * 128 + (h >> 2) * 64), 128,
                                        (attn_body::bf16*)(X2 + r0 * 1024 + 256 + h * 64), 1024, 4, (char*)lds_raw, dry);
            }
        }
        }
#endif
#ifndef SKIP_D1
        asm volatile("; MARK_SKIP_D1" ::: "memory");
        { PHASE_LOCALS();
        {
            unsigned char* ws = WSP; const float* conv_w = INP(17); const bf16* Zb = (const bf16*)(ws + WS_Z); const float* BG = (const float*)(ws + WS_BG); unsigned char* DN = ws + WS_DN;
            const int dir = wave >> 2, gwv = wave & 3;
            LAS unsigned char* db = lds + DN_DIRB + dir * DN_DIRSZ;
            LAS float* sc_beta = (LAS float*)(db + DN_SC); LAS float* sc_gc = sc_beta + 64; LAS float* sc_egc = sc_beta + 128; LAS float* sc_edec = sc_beta + 192; LAS float* sc_egl = sc_beta + 256;
#define DN_PREFETCH(it_) do { const int cg_ = (it_) >> 2, h_ = (it_) & 3, r0_ = cg_ * 64; \
        const int sq0_ = r0_ < NPR ? (r0_ & ~255) : NPR + ((r0_ - NPR) & ~4095), L_ = r0_ < NPR ? 256 : 4096, tb_ = r0_ - sq0_ + 8 * wave - 2; \
        const bf16* zq_ = Zb + (size_t)sq0_ * 1024 + 256 + h_ * 64 + lane; \
        bf16 rq_[11], rk_[11], rv_[11]; \
        _Pragma("unroll") for (int j_ = 0; j_ < 11; ++j_) { const int tt_ = tb_ + j_, tc_ = min(max(tt_, 0), L_ - 1); const bf16* p_ = zq_ + (size_t)tc_ * 1024; rq_[j_] = p_[0]; rk_[j_] = p_[256]; rv_[j_] = p_[512]; }     \
        _Pragma("unroll") for (int j_ = 0; j_ < 11; ++j_) { const int tt_ = tb_ + j_; const bool ok_ = (tt_ >= 0 && tt_ < L_); pfq[j_] = ok_ ? bf1(rq_[j_]) : 0.f; pfk[j_] = ok_ ? bf1(rk_[j_]) : 0.f; pfv[j_] = ok_ ? bf1(rv_[j_]) : 0.f; } \
        const float* cw_ = conv_w + (size_t)l * 4 * 768 + h_ * 64 + lane; \
        _Pragma("unroll") for (int j_ = 0; j_ < 4; ++j_) { pfw[j_] = cw_[j_ * 768]; pfw[4 + j_] = cw_[j_ * 768 + 256]; pfw[8 + j_] = cw_[j_ * 768 + 512]; } \
        const float* bg_ = BG + (size_t)(r0_ + lane) * 16; pfb[0] = bg_[dir * 4 + h_]; pfb[1] = bg_[8 + dir * 4 + h_]; } while (0)
            xcd_wait(bar, 5 + 2 * l);
            const bool isA = (vcu & 31) < 16; const int hrank = (vcu >> 5) * 16 + (vcu & 15);
            v4u xin[3][4];
#define DN_XIN(it_) do { const int cgi_ = (it_) >> 2, h_ = (it_) & 3; int lnx_ = lane; asm volatile("" : "+v"(lnx_)); const int i_ = 8 * wave + (lnx_ >> 3); \
        const int r0x_ = cgi_ * 64, sq0x_ = r0x_ < NPR ? (r0x_ & ~255) : NPR + ((r0x_ - NPR) & ~4095), Lx_ = r0x_ < NPR ? 256 : 4096, tx_ = r0x_ - sq0x_ + i_; \
        _Pragma("unroll") for (int j_ = 0; j_ < 4; ++j_) { const int tc_ = min(max(tx_ - 2 + j_, 0), Lx_ - 1); const bf16* p_ = Zb + (size_t)(sq0x_ + tc_) * 1024 + 256 + h_ * 64 + (lnx_ & 7) * 8; \
            _Pragma("unroll") for (int sg_ = 0; sg_ < 3; ++sg_) xin[sg_][j_] = *(const v4u*)(p_ + sg_ * 256); } } while (0)
            DN_XIN((isA ? 0 : 640) + hrank);
            __builtin_amdgcn_s_waitcnt(0x0F70);
            const int first = (isA ? 0 : 640) + hrank, hh = first & 3, nstat = isA ? 3 : 5;
            unsigned* pool_ctr = (unsigned*)(ws + WS_CTL) + 512 + l * 4 + hh;
            int it = first, kst = 0;
            for (;;) {
                const int cgi = it >> 2, h = it & 3;
                const bool stat_next = kst + 1 < nstat;
                unsigned claim = 0u;
                if (!stat_next && tid == 0) claim = __hip_atomic_fetch_add(pool_ctr, 1u, __ATOMIC_RELAXED, __HIP_MEMORY_SCOPE_AGENT);
                {
                    float pfb[2];
                    { const float* bg_ = BG + (size_t)(cgi * 64 + lane) * 16; pfb[0] = bg_[dir * 4 + h]; pfb[1] = bg_[8 + dir * 4 + h]; }
                    const float be_pf = pfb[0], g_pf = pfb[1];
                    {
                        int ln_ = lane; asm volatile("" : "+v"(ln_));
                        const int rI = ln_ >> 3, cgp = ln_ & 7, i = 8 * wave + rI;
                        const int r0_ = cgi * 64, sq0_ = r0_ < NPR ? (r0_ & ~255) : NPR + ((r0_ - NPR) & ~4095), L_ = r0_ < NPR ? 256 : 4096, t_ = r0_ - sq0_ + i;
                        f32x4 tw[3][4][2];
                        { const LAS float* cw_ = (const LAS float*)(lds + DN_TAPS) + cgp * 8;
#pragma unroll
                          for (int sg = 0; sg < 3; ++sg)
#pragma unroll
                              for (int j = 0; j < 4; ++j) { tw[sg][j][0] = *(const LAS f32x4*)(cw_ + (j * 3 + sg) * 64); tw[sg][j][1] = *(const LAS f32x4*)(cw_ + (j * 3 + sg) * 64 + 4); } }
                        float y[3][8];
#pragma unroll
                        for (int sg = 0; sg < 3; ++sg)
#pragma unroll
                            for (int c = 0; c < 8; ++c) y[sg][c] = 0.f;
#pragma unroll
                        for (int j = 0; j < 4; ++j) { const int tt = t_ - 2 + j; const bool ok = (tt >= 0 && tt < L_);
#pragma unroll
                            for (int sg = 0; sg < 3; ++sg)
#pragma unroll
                                for (int d = 0; d < 4; ++d) { const unsigned u = ok ? xin[sg][j][d] : 0u;
                                    y[sg][2 * d] += tw[sg][j][d >> 1][(2 * d) & 3] * bflo(u); y[sg][2 * d + 1] += tw[sg][j][d >> 1][(2 * d + 1) & 3] * bfhi(u); } }
                        float ssq = 0.f, ssk = 0.f;
#pragma unroll
                        for (int c = 0; c < 8; ++c) { y[0][c] = fsilu(y[0][c]); y[1][c] = fsilu(y[1][c]); y[2][c] = fsilu(y[2][c]); ssq += y[0][c] * y[0][c]; ssk += y[1][c] * y[1][c]; }
                        ssq += __int_as_float(__builtin_amdgcn_update_dpp(0, __float_as_int(ssq), 0xB1, 0xF, 0xF, true)); ssk += __int_as_float(__builtin_amdgcn_update_dpp(0, __float_as_int(ssk), 0xB1, 0xF, 0xF, true));
                        ssq += __int_as_float(__builtin_amdgcn_update_dpp(0, __float_as_int(ssq), 0x4E, 0xF, 0xF, true)); ssk += __int_as_float(__builtin_amdgcn_update_dpp(0, __float_as_int(ssk), 0x4E, 0xF, 0xF, true));
                        ssq += __int_as_float(__builtin_amdgcn_update_dpp(0, __float_as_int(ssq), 0x141, 0xF, 0xF, true)); ssk += __int_as_float(__builtin_amdgcn_update_dpp(0, __float_as_int(ssk), 0x141, 0xF, 0xF, true));
                        const float rq = rsqrtf(ssq + EPS) * 0.125f, rk = rsqrtf(ssk + EPS);
                        v4u oq, ok8, ov;
#pragma unroll
                        for (int d = 0; d < 4; ++d) { oq[d] = pk2(y[0][2 * d] * rq, y[0][2 * d + 1] * rq); ok8[d] = pk2(y[1][2 * d] * rk, y[1][2 * d + 1] * rk); ov[d] = pk2(y[2][2 * d], y[2][2 * d + 1]); }
                        *(LAS v4u*)(lds + DN_TQN + i * DN_TS + cgp * 16) = oq;
                        *(LAS v4u*)(lds + DN_TKN + i * DN_TS + cgp * 16) = ok8;
                        *(LAS v4u*)(lds + DN_TVN + i * DN_TS + cgp * 16) = ov;
#pragma unroll
                        for (int d = 0; d < 4; ++d) { *(LAS bf16*)(lds + DN_TKT + (8 * cgp + 2 * d) * DN_TS + i * 2) = (bf16)(ok8[d] & 0xffffu); *(LAS bf16*)(lds + DN_TKT + (8 * cgp + 2 * d + 1) * DN_TS + i * 2) = (bf16)(ok8[d] >> 16); }
                    }
                    if (gwv == 0) {
                        int ln = lane; asm volatile("" : "+v"(ln));
                        const float be = be_pf; float gc, gl_;
                        {
                            float v = g_pf;
                            v += __int_as_float(__builtin_amdgcn_update_dpp(0, __float_as_int(v), 0x111, 0xF, 0xF, true));
                            v += __int_as_float(__builtin_amdgcn_update_dpp(0, __float_as_int(v), 0x112, 0xF, 0xF, true));
                            v += __int_as_float(__builtin_amdgcn_update_dpp(0, __float_as_int(v), 0x114, 0xF, 0xF, true));
                            v += __int_as_float(__builtin_amdgcn_update_dpp(0, __float_as_int(v), 0x118, 0xF, 0xF, true));
                            v += __int_as_float(__builtin_amdgcn_update_dpp(0, __float_as_int(v), 0x142, 0xA, 0xF, false));
                            v += __int_as_float(__builtin_amdgcn_update_dpp(0, __float_as_int(v), 0x143, 0xC, 0xF, false));
                            const float tot = __int_as_float(__builtin_amdgcn_readlane(__float_as_int(v), 63));
                            gc = dir == 0 ? v : tot - v + g_pf;
                            gl_ = tot; }
                        const float gl = gl_;
                        sc_beta[ln] = be; sc_gc[ln] = gc; sc_egc[ln] = __expf(gc); sc_edec[ln] = __expf(gl - gc); if (ln == 0) sc_egl[0] = __expf(gl);
                    }
                }
                __syncthreads();
                f32x4 at[4];
                {
                    const int i = 16 * gwv + fr; bf16x8 xkf[2], xqf[2];
#pragma unroll
                    for (int s = 0; s < 2; ++s) { xkf[s] = *(const LAS bf16x8*)(lds + DN_TKN + i * DN_TS + (32 * s + 8 * fq) * 2); xqf[s] = *(const LAS bf16x8*)(lds + DN_TQN + i * DN_TS + (32 * s + 8 * fq) * 2); }
                    const float gci = sc_gc[i], bei = sc_beta[i]; f32x4 LA = (f32x4){0.f, 0.f, 0.f, 0.f}, LB = LA;
#pragma unroll
                    for (int nt = 0; nt < 4; ++nt) {
                        f32x4 ga = (f32x4){0.f, 0.f, 0.f, 0.f}, qa = (f32x4){0.f, 0.f, 0.f, 0.f};
#pragma unroll
                        for (int s = 0; s < 2; ++s) { const bf16x8 wf = *(const LAS bf16x8*)(lds + DN_TKN + (16 * nt + fr) * DN_TS + (32 * s + 8 * fq) * 2); ga = mfma16(wf, xkf[s], ga); qa = mfma16(wf, xqf[s], qa); }
                        const f32x4 gcj = *(const LAS f32x4*)(sc_gc + 16 * nt + 4 * fq); f32x4 Lv;
#pragma unroll
                        for (int e = 0; e < 4; ++e) { const int j = 16 * nt + 4 * fq + e; const bool incl = dir == 0 ? (j <= i) : (j >= i);
                            const float dec = incl ? __expf(gci - gcj[e]) : 0.f;
                            Lv[e] = (j != i) ? bei * ga[e] * dec : 0.f; at[nt][e] = qa[e] * dec; }
                        *(LAS f32x4*)(db + DN_LF + i * 272 + (16 * nt + 4 * fq) * 4) = Lv;
                        if (nt == gwv) {
                            LA = Lv; const f32x4 bej = *(const LAS f32x4*)(sc_beta + 16 * nt + 4 * fq);
#pragma unroll
                            for (int e = 0; e < 4; ++e) { const int j = 16 * nt + 4 * fq + e; const bool nz = dir == 0 ? (i < j) : (i > j);
                                LB[e] = nz ? bej[e] * ga[e] * __expf(gcj[e] - gci) : 0.f; } }
                    }
                    {
#define DN_CV(v_) __builtin_bit_cast(s16x4, (v2u){pk2((v_)[0], (v_)[1]), pk2((v_)[2], (v_)[3])})
                        const f32x4 zz = (f32x4){0.f, 0.f, 0.f, 0.f};
                        const s16x4 la = DN_CV(LA), lb = DN_CV(LB);
                        const f32x4 M2 = mfma16k16(lb, la, zz), L2 = mfma16k16(la, lb, zz);
                        const s16x4 m2 = DN_CV(M2), l2 = DN_CV(L2);
                        f32x4 X;
#pragma unroll
                        for (int e = 0; e < 4; ++e) X[e] = ((4 * fq + e) == fr ? 1.f : 0.f) - LA[e];
                        X = mfma16k16(l2, DN_CV(X), X);
                        const f32x4 M4 = mfma16k16(l2, m2, zz), L4 = mfma16k16(m2, l2, zz);
                        const s16x4 m4 = DN_CV(M4), l4 = DN_CV(L4);
                        X = mfma16k16(l4, DN_CV(X), X);
                        const f32x4 L8 = mfma16k16(m4, l4, zz);
                        X = mfma16k16(DN_CV(L8), DN_CV(X), X);
                        if (dir == 0) *(LAS v2u*)(db + DN_TI + gwv * 512 + fr * 32 + fq * 8) = (v2u){pk2(X[0], X[1]), pk2(X[2], X[3])};
                        else *(LAS v2u*)(db + DN_TI + (3 - gwv) * 512 + (15 - fr) * 32 + (12 - 4 * fq) * 2) = (v2u){pk2(X[3], X[2]), pk2(X[1], X[0])};
#undef DN_CV
                    }
                }
                __syncthreads();
                if (dir == 0) dn_subst<0>(lds, db, gwv, lane); else dn_subst<1>(lds, db, gwv, lane);
                if (!stat_next && tid == 0) MISC[100] = claim;
                __syncthreads();
                int itn; bool more;
                if (stat_next) { itn = it + 128; more = true; }
                else { const unsigned c_ = MISC[100]; more = c_ < 128u; itn = more ? (c_ < 64u ? 384 + 4 * (int)c_ + hh : 1280 + 4 * ((int)c_ - 64) + hh) : it; }
                DN_XIN(itn);
                {
                    const int i = 16 * gwv + fr;
#pragma unroll
                    for (int nt = 0; nt < 4; ++nt) { v2u o; o.x = pk2(at[nt][0], at[nt][1]); o.y = pk2(at[nt][2], at[nt][3]); *(LAS v2u*)(db + DN_LF + i * DN_TS + (16 * nt + 4 * fq) * 2) = o; }
                }
                __syncthreads();
                {
                    const LAS unsigned char* XB = gwv == 0 ? (lds + DN_TKT) : gwv == 1 ? (db + DN_UDT) : (db + DN_LF);
                    const LAS unsigned char* WB = gwv == 0 ? (db + DN_WDT) : gwv == 1 ? (lds + DN_TKT) : gwv == 2 ? (db + DN_WT) : (db + DN_UT);
                    f32x4 acc[4][4];
#pragma unroll
                    for (int mt = 0; mt < 4; ++mt)
#pragma unroll
                        for (int nt = 0; nt < 4; ++nt) acc[mt][nt] = (f32x4){0.f, 0.f, 0.f, 0.f};
#pragma unroll
                    for (int s = 0; s < 2; ++s) { bf16x8 xf[4], wf[4];
#pragma unroll
                        for (int t = 0; t < 4; ++t) { xf[t] = *(const LAS bf16x8*)(XB + (16 * t + fr) * DN_TS + (32 * s + 8 * fq) * 2); wf[t] = *(const LAS bf16x8*)(WB + (16 * t + fr) * DN_TS + (32 * s + 8 * fq) * 2); }
#pragma unroll
                        for (int mt = 0; mt < 4; ++mt)
#pragma unroll
                            for (int nt = 0; nt < 4; ++nt) acc[mt][nt] = mfma16(wf[nt], xf[mt], acc[mt][nt]); }
                    unsigned char* dn = DN + (size_t)((cgi * 4 + h) * 2 + dir) * 32768 + gwv * 8192;
                    const float egl = sc_egl[0];
                    __builtin_amdgcn_s_waitcnt(0x0F70);
                    LAS unsigned char* stg = lds + (dir == 0 ? DN_TKN : DN_TVN) + gwv * 2304;
#pragma unroll
                    for (int mt = 0; mt < 4; ++mt) { const int m = 16 * mt + fr; const float egi = sc_egc[m];
#pragma unroll
                        for (int nt = 0; nt < 4; ++nt) { f32x4 v = acc[mt][nt]; int coff = 16 * nt + 4 * fq;
                            if (gwv == 0) { coff = 32 * (nt >> 1) + 8 * fq + 4 * (nt & 1);
#pragma unroll
                                for (int e = 0; e < 4; ++e) v[e] = ((m == 16 * nt + 4 * fq + e) ? egl : 0.f) - v[e]; }
                            else if (gwv == 2) { const v2u qq = *(const LAS v2u*)(lds + DN_TQN + m * DN_TS + (16 * nt + 4 * fq) * 2);
                                v[0] = egi * bflo(qq.x) - v[0]; v[1] = egi * bfhi(qq.x) - v[1]; v[2] = egi * bflo(qq.y) - v[2]; v[3] = egi * bfhi(qq.y) - v[3]; }
                            v2u o; o.x = pk2(v[0], v[1]); o.y = pk2(v[2], v[3]);
                            *(LAS v2u*)(stg + fr * 144 + coff * 2) = o; }
#pragma unroll
                        for (int j = 0; j < 2; ++j) { const int r = (lane >> 3) + 8 * j; const v4u x = *(const LAS v4u*)(stg + r * 144 + (lane & 7) * 16); *(v4u*)(dn + (16 * mt + r) * 128 + (lane & 7) * 16) = x; } }
                }
                asm volatile("s_waitcnt lgkmcnt(0)\n\ts_barrier" ::: "memory");
                if (!more) break;
                it = itn; ++kst;
            }
        }
#undef DN_PREFETCH
#undef DN_XIN
        }
#endif
        GRID_BAR();
#ifndef SKIP_SCAN
        asm volatile("; MARK_SKIP_SCAN" ::: "memory");
        { PHASE_LOCALS();
        {
            const bool dry = false;
            unsigned char* ws = WSP; float* out = OUTP; const float* state_in = INP(4); const unsigned char* DN = ws + WS_DN; unsigned char* STb = ws + WS_Z;
            const int xq = vcu >> 5, jq = vcu & 31;
            const int rk = xq * 24 + (jq - 8);
            if (jq < 8) {
                const int sidx = (xq * 8 + jq) >> 1, hf = jq & 1, b = sidx >> 3, h = (sidx >> 1) & 3, dir = sidx & 1, cg0 = 128 + b * 64;
#define SC_OFF(st_) ((size_t)(((cg0 + (dir ? 63 - (st_) : (st_))) * 4 + h) * 2 + dir) * 32768)
#define SC_BAR() asm volatile("s_waitcnt lgkmcnt(0)\n\ts_barrier" ::: "memory")
                const unsigned lo_ = (unsigned)((lane >> 3) * 128 + (((lane & 7) ^ ((lane >> 3) & 7)) << 4));
                const unsigned char* DNm = DN + (size_t)wave * 1024 + lo_;
                const unsigned char* DNn = DN + 8192 + (size_t)(4 * hf + (wave & 3)) * 1024 + lo_;
                LAS unsigned char* wbm = lds + wave * 1024 + lane * 16;
                LAS unsigned char* wbn = lds + 8192 + (4 * hf + (wave & 3)) * 1024 + lane * 16;
                v4u R[8][2];
#define SC_LD2(buf_, st_) do { const size_t o_ = SC_OFF(min((st_), 63)); R[buf_][0] = *(const v4u*)(DNm + o_); R[buf_][1] = *(const v4u*)(DNn + o_); } while (0)
#define SC_LD1(buf_, st_) do { const size_t o_ = SC_OFF(min((st_), 63)); R[buf_][0] = *(const v4u*)(DNm + o_); } while (0)
#define SC_PUTB2(bi_, sl_, ld_) do { *(LAS v4u*)(wbm + (sl_) * 16384) = R[bi_][0]; *(LAS v4u*)(wbn + (sl_) * 16384) = R[bi_][1]; SC_LD2(bi_, (ld_)); SC_BAR(); } while (0)
#define SC_PUTB1(bi_, sl_, ld_) do { *(LAS v4u*)(wbm + (sl_) * 16384) = R[bi_][0]; SC_LD1(bi_, (ld_)); SC_BAR(); } while (0)
                if (wave < 2) {
                    const int mt = 2 * hf + wave;
                    f32x4 S[4];
                    { const float* sp = state_in + ((size_t)(((b * 2 + l) * 2 + dir) * 4 + h)) * 4096 + 16 * mt + fr;
#pragma unroll
                      for (int nt = 0; nt < 4; ++nt)
#pragma unroll
                          for (int e = 0; e < 4; ++e) S[nt][e] = sp[(16 * nt + 4 * fq + e) * 64]; }
#pragma unroll
                    for (int k = 0; k < 8; ++k) SC_LD2(k, k);
                    LAS unsigned char* aM = lds + fr * 128; LAS unsigned char* aN = lds + 8192 + (16 * mt + fr) * 128 + 8 * (fq & 1); const int sw = fr & 7;
                    bf16x8 mfb[2][8]; v2u nfb[2][4];
#define SC_FRAG(q_) do { \
        _Pragma("unroll") for (int nt_ = 0; nt_ < 4; ++nt_) _Pragma("unroll") for (int s_ = 0; s_ < 2; ++s_) mfb[q_][nt_ * 2 + s_] = *(const LAS bf16x8*)(aM + (q_) * 16384 + nt_ * 2048 + (((4 * s_ + fq) ^ sw) << 4)); \
        _Pragma("unroll") for (int nt_ = 0; nt_ < 4; ++nt_) nfb[q_][nt_] = *(const LAS v2u*)(aN + (q_) * 16384 + (((2 * nt_ + (fq >> 1)) ^ sw) << 4)); } while (0)
                    SC_PUTB2(0, 0, 8);
                    SC_FRAG(0);
                    __builtin_amdgcn_s_setprio(2);
                    for (int st = 0; st < 64; st += 8) {
#pragma unroll
                        for (int k = 0; k < 8; ++k) {
                            SC_PUTB2((k + 1) & 7, (k + 1) & 1, st + k + 9);
                            SC_FRAG((k + 1) & 1);
                            const bf16x8* mf = mfb[k & 1]; const v2u* nf = nfb[k & 1];
                            unsigned sw_[8];
#pragma unroll
                            for (int nt = 0; nt < 4; ++nt) { sw_[2 * nt] = pk2(S[nt][0], S[nt][1]); sw_[2 * nt + 1] = pk2(S[nt][2], S[nt][3]); }
                            { LAS unsigned char* sp_ = lds + 32768 + (k & 1) * 9216 + wave * 2304 + fr * 144 + 8 * fq;
#pragma unroll
                              for (int nt = 0; nt < 4; ++nt) *(LAS v2u*)(sp_ + 32 * nt) = (v2u){sw_[2 * nt], sw_[2 * nt + 1]}; }
                            bf16x8 xs_[2];
#pragma unroll
                            for (int s = 0; s < 2; ++s) xs_[s] = __builtin_bit_cast(bf16x8, (v4u){sw_[4 * s], sw_[4 * s + 1], sw_[4 * s + 2], sw_[4 * s + 3]});
#pragma unroll
                            for (int nt = 0; nt < 4; ++nt) { f32x4 c_ = (f32x4){bflo(nf[nt].x), bfhi(nf[nt].x), bflo(nf[nt].y), bfhi(nf[nt].y)};
                                c_ = mfma16(mf[nt * 2 + 0], xs_[0], c_); c_ = mfma16(mf[nt * 2 + 1], xs_[1], c_); S[nt] = c_; }
                        }
                    }
                    __builtin_amdgcn_s_setprio(0);
                    SC_BAR();
#undef SC_FRAG
                } else if (wave < 4) {
#pragma unroll
                    for (int k = 0; k < 8; ++k) SC_LD2(k, k);
                    SC_PUTB2(0, 0, 8);
                    for (int st = 0; st < 64; st += 8) {
#pragma unroll
                        for (int k = 0; k < 8; ++k) SC_PUTB2((k + 1) & 7, (k + 1) & 1, st + k + 9);
                    }
                    SC_BAR();
                } else {
#pragma unroll
                    for (int k = 0; k < 8; ++k) SC_LD1(k, k);
                    SC_PUTB1(0, 0, 8);
                    const int c = wave & 1; const bool cp = wave < 6;
                    LAS unsigned char* gs = lds + 32768 + c * 2304 + (lane >> 3) * 144 + (lane & 7) * 16;
                    unsigned char* gd = STb + ((size_t)(16 * (2 * hf + c) + (lane >> 3)) * 1024 + 256 + (h * 2 + dir) * 64 + (lane & 7) * 8) * 2;
#define SC_OUT(kb_, s_) do { if (cp) { const v4u x0_ = *(const LAS v4u*)(gs + (kb_) * 9216), x1_ = *(const LAS v4u*)(gs + (kb_) * 9216 + 8 * 144); \
        unsigned char* d_ = gd + (size_t)(cg0 + (dir ? 63 - (s_) : (s_))) * (64 * 2048); *(v4u*)d_ = x0_; *(v4u*)(d_ + 8 * 2048) = x1_; } } while (0)
                    for (int st = 0; st < 64; st += 8) {
#pragma unroll
                        for (int k = 0; k < 8; ++k) { SC_PUTB1((k + 1) & 7, (k + 1) & 1, st + k + 9); if (st + k > 0) SC_OUT((k + 1) & 1, st + k - 1); }
                    }
                    SC_BAR(); SC_OUT(1, 63);
#undef SC_OUT
                }
#undef SC_PUTB1
#undef SC_PUTB2
#undef SC_LD1
#undef SC_LD2
#undef SC_BAR
#undef SC_OFF
                __syncthreads();
            } else {
            if (rk < 128) {
                const int p = rk * 8 + wave, sidx = p >> 2, mt = p & 3, nch = 4, cg0 = (sidx >> 3) * 4;
                const int b = sidx >> 3, h = (sidx >> 1) & 3, dir = sidx & 1;
                f32x4 S[4];
#pragma unroll
                for (int nt = 0; nt < 4; ++nt) S[nt] = (f32x4){0.f, 0.f, 0.f, 0.f};
                bf16x8 mf[4][8]; v2u nf[4][4];
#define SC_ID(st_) ((size_t)(((cg0 + (dir ? nch - 1 - (st_) : (st_))) * 4 + h) * 2 + dir))
#define SC_LOAD(buf_, st_) do { const unsigned char* dn_ = DN + SC_ID(st_) * 32768; \
    _Pragma("unroll") for (int nt_ = 0; nt_ < 4; ++nt_) _Pragma("unroll") for (int s_ = 0; s_ < 2; ++s_) mf[buf_][nt_ * 2 + s_] = *(const bf16x8*)(dn_ + (16 * nt_ + fr) * 128 + (32 * s_ + 8 * fq) * 2); \
    _Pragma("unroll") for (int nt_ = 0; nt_ < 4; ++nt_) nf[buf_][nt_] = *(const v2u*)(dn_ + 8192 + (16 * mt + fr) * 128 + (16 * nt_ + 4 * fq) * 2); } while (0)
#define SC_STEP(buf_, st_) do { \
    unsigned sw_[8]; \
    _Pragma("unroll") for (int nt_ = 0; nt_ < 4; ++nt_) { sw_[2 * nt_] = pk2(S[nt_][0], S[nt_][1]); sw_[2 * nt_ + 1] = pk2(S[nt_][2], S[nt_][3]); } \
    { LAS unsigned char* sg_ = lds + wave * 18944 + ((st_) & 1) * 2304;        \
      _Pragma("unroll") for (int nt_ = 0; nt_ < 4; ++nt_) *(LAS v2u*)(sg_ + fr * 144 + 8 * fq + 32 * nt_) = (v2u){sw_[2 * nt_], sw_[2 * nt_ + 1]}; \
      unsigned char* sp_ = STb + ((size_t)((cg0 + (dir ? nch - 1 - (st_) : (st_))) * 64 + 16 * mt + (lane >> 3)) * 1024 + 256 + (h * 2 + dir) * 64 + (lane & 7) * 8) * 2; \
      _Pragma("unroll") for (int j_ = 0; j_ < 2; ++j_) { const v4u x_ = *(const LAS v4u*)(sg_ + ((lane >> 3) + 8 * j_) * 144 + (lane & 7) * 16); *(v4u*)(sp_ + j_ * 8 * 2048) = x_; } } \
    bf16x8 xs_[2]; \
    _Pragma("unroll") for (int s_ = 0; s_ < 2; ++s_) xs_[s_] = __builtin_bit_cast(bf16x8, (v4u){sw_[4 * s_], sw_[4 * s_ + 1], sw_[4 * s_ + 2], sw_[4 * s_ + 3]}); \
    _Pragma("unroll") for (int nt_ = 0; nt_ < 4; ++nt_) { f32x4 c_ = (f32x4){bflo(nf[buf_][nt_].x), bfhi(nf[buf_][nt_].x), bflo(nf[buf_][nt_].y), bfhi(nf[buf_][nt_].y)}; \
        c_ = mfma16(mf[buf_][nt_ * 2 + 0], xs_[0], c_); c_ = mfma16(mf[buf_][nt_ * 2 + 1], xs_[1], c_); S[nt_] = c_; } } while (0)
                SC_LOAD(0, 0); SC_LOAD(1, 1); SC_LOAD(2, 2); SC_LOAD(3, 3);
                SC_STEP(0, 0); SC_STEP(1, 1); SC_STEP(2, 2); SC_STEP(3, 3);
#undef SC_STEP
#undef SC_LOAD
#undef SC_ID
                { float* op = out + OUT_S + ((size_t)(((b * 2 + l) * 2 + dir) * 4 + h)) * 4096 + 16 * mt + fr;
#pragma unroll
                    for (int nt = 0; nt < 4; ++nt)
#pragma unroll
                        for (int e = 0; e < 4; ++e) op[(16 * nt + 4 * fq + e) * 64] = S[nt][e]; }
            }
            {
                const float* pool_scale = INP(14); bf16* X2 = (bf16*)(ws + WS_X2); const bf16* Zb = (const bf16*)(ws + WS_Z); const bf16* poolT = (const bf16*)(ws + WS_POOLW);
                const int g = wave & 3, wsz = 2 << g, half = wsz >> 1;
                const int pitA = rk * 8 + wave, pitB0 = 1536 + ((rk + 64) % 192) * 8 + wave; const bool hasB = pitB0 < 3072; const int pitB = hasB ? pitB0 : pitA;
                auto issue = [&](const int pit, v4u (&rr)[6], v4u (&gt)[4]) {
                    const int row0 = (pit >> 2) * 32, seq0 = row0 < NPR ? (row0 & ~255) : NPR + ((row0 - NPR) & ~4095), L = row0 < NPR ? 256 : 4096, tlo = row0 - seq0 - 8;
#pragma unroll
                    for (int j = 0; j < 6; ++j) { const int tc = min(max(tlo + 8 * j + (lane >> 3), 0), L - 1); rr[j] = *(const v4u*)(Zb + (size_t)(seq0 + tc) * 1024 + g * 64 + (lane & 7) * 8); }
#pragma unroll
                    for (int j = 0; j < 4; ++j) gt[j] = *(const v4u*)(X2 + (size_t)(row0 + 8 * j + (lane >> 3)) * 1024 + g * 64 + (lane & 7) * 8);
                };
                v4u rrA[6], gtA[4], rrB[6], gtB[4];
                issue(pitA, rrA, gtA); issue(pitB, rrB, gtB);
                bf16x8 wfr[2][4]; f32x4 psv[4];
                { const bf16* wp = poolT + (size_t)((l * 4 + g) * 64) * 64;
#pragma unroll
                  for (int s = 0; s < 2; ++s)
#pragma unroll
                      for (int nt = 0; nt < 4; ++nt) wfr[s][nt] = *(const bf16x8*)(wp + (size_t)(16 * nt + fr) * 64 + 32 * s + 8 * fq);
#pragma unroll
                  for (int nt = 0; nt < 4; ++nt) psv[nt] = *(const f32x4*)(pool_scale + l * 256 + g * 64 + 16 * nt + 4 * fq); }
                auto body = [&](const int pit, const v4u (&rr)[6], const v4u (&gtr)[4]) {
                    const int row0 = (pit >> 2) * 32;
                    const int seq0 = row0 < NPR ? (row0 & ~255) : NPR + ((row0 - NPR) & ~4095); const int L = row0 < NPR ? 256 : 4096;
                    LAS float* cs = (LAS float*)(lds + wave * 18944);
                    LAS unsigned char* pl = lds + wave * 18944 + 12544;
                    const int t0 = row0 - seq0, tlo = t0 - 8;
                    LAS unsigned char* raw = lds + wave * 18944;
#pragma unroll
                    for (int j = 0; j < 6; ++j) *(LAS v4u*)(raw + (8 * j + (lane >> 3)) * 128 + (lane & 7) * 16) = rr[j];
                    asm volatile("" ::: "memory");
                    bf16 xr[48];
#pragma unroll
                    for (int i = 0; i < 48; ++i) xr[i] = *(const LAS bf16*)(raw + i * 128 + lane * 2);
                    asm volatile("s_waitcnt lgkmcnt(0)" ::: "memory");
                    float run = 0.f; cs[lane] = 0.f;
#pragma unroll
                    for (int i = 0; i < 48; ++i) { const int tt = tlo + i; const float x = (tt >= 0 && tt < L) ? bf1(xr[i]) : 0.f; run += x; cs[(i + 1) * 64 + lane] = run; }
#pragma unroll
                    for (int j = 0; j < 32; ++j) { const int t = t0 + j; const int lo = max(t - half, 0), hi = min(t - half + wsz, L);
                        const float rc = 1.0f / (float)(hi - lo);
                        const float pv = (cs[(hi - tlo) * 64 + lane] - cs[(lo - tlo) * 64 + lane]) * rc - bf1(xr[j + 8]);
                        *(LAS bf16*)(pl + j * 144 + lane * 2) = (bf16)f2bf(pv); }
                    asm volatile("" ::: "memory");
                    bf16x8 xf[2][2];
#pragma unroll
                    for (int mt = 0; mt < 2; ++mt)
#pragma unroll
                        for (int s = 0; s < 2; ++s) xf[mt][s] = *(const LAS bf16x8*)(pl + (16 * mt + fr) * 144 + (32 * s + 8 * fq) * 2);
                    f32x4 acc[2][4];
#pragma unroll
                    for (int mt = 0; mt < 2; ++mt)
#pragma unroll
                        for (int nt = 0; nt < 4; ++nt) acc[mt][nt] = (f32x4){0.f, 0.f, 0.f, 0.f};
#pragma unroll
                    for (int s = 0; s < 2; ++s)
#pragma unroll
                        for (int nt = 0; nt < 4; ++nt)
#pragma unroll
                            for (int mt = 0; mt < 2; ++mt) acc[mt][nt] = mfma16(wfr[s][nt], xf[mt][s], acc[mt][nt]);
                    LAS unsigned char* og = lds + wave * 18944;
#pragma unroll
                    for (int mt = 0; mt < 2; ++mt)
#pragma unroll
                        for (int nt = 0; nt < 4; ++nt) { const f32x4 ps = psv[nt]; const f32x4 a = acc[mt][nt];
                            v2u o; o.x = pk2(a[0] * ps[0], a[1] * ps[1]); o.y = pk2(a[2] * ps[2], a[3] * ps[3]);
                            *(LAS v2u*)(og + (16 * mt + fr) * 144 + (16 * nt + 4 * fq) * 2) = o; }
#pragma unroll
                    for (int j = 0; j < 4; ++j) { const v4u x = *(const LAS v4u*)(og + (8 * j + (lane >> 3)) * 144 + (lane & 7) * 16); const v4u gt = gtr[j]; v4u o;
#pragma unroll
                        for (int e = 0; e < 4; ++e) o[e] = pk2(bflo(x[e]) * bflo(gt[e]), bfhi(x[e]) * bfhi(gt[e]));
                        *(v4u*)(X2 + (size_t)(row0 + 8 * j + (lane >> 3)) * 1024 + g * 64 + (lane & 7) * 8) = dry ? gt : o; }
                    asm volatile("s_waitcnt lgkmcnt(0)" ::: "memory");
                };
                body(pitA, rrA, gtA);
                if (hasB) body(pitB, rrB, gtB);
            }
            }
        }
        }
#endif
        GRID_BAR();
#ifndef SKIP_D3
        asm volatile("; MARK_SKIP_D3" ::: "memory");
        { PHASE_LOCALS();
        {
#ifdef PROBE_D3
            const bool dry = (rep_ == 0);
#else
            const bool dry = false;
#endif
            unsigned char* ws = WSP; const float* o_norm = INP(20); const unsigned char* DN = ws + WS_DN; const unsigned char* STb = ws + WS_Z; bf16* X2 = (bf16*)(ws + WS_X2);
            LAS unsigned char* SST = lds;
            LAS unsigned char* wv = lds + 36864 + wave * 13824;
            const int r8 = lane >> 3, c8 = lane & 7;
            const int pr = wave >> 2, h = (vcu & 1) * 2 + pr, mt = wave & 3;
            v4u sx[4], px[2][2], rx[2][2], gx[2]; f32x4 onv[4];
#pragma unroll
            for (int nt = 0; nt < 4; ++nt) onv[nt] = *(const f32x4*)(o_norm + l * 64 + 16 * nt + 4 * fq);
            auto issue = [&](const int it) {
                const int cgi = (vcu >> 1) + 128 * it; const size_t id0 = (size_t)((cgi * 4 + h) * 2);
                { const int ds = (wave >> 1) & 1; const unsigned char* st = STb + ((size_t)(cgi * 64 + 32 * (wave & 1) + r8) * 1024 + 256 + (h * 2 + ds) * 64 + c8 * 8) * 2;
#pragma unroll
                  for (int j = 0; j < 4; ++j) sx[j] = *(const v4u*)(st + (size_t)j * 8 * 2048); }
#pragma unroll
                for (int d = 0; d < 2; ++d) { const unsigned char* dn = DN + (id0 + d) * 32768 + (16 * mt + r8) * 128 + c8 * 16;
#pragma unroll
                    for (int j = 0; j < 2; ++j) { px[d][j] = *(const v4u*)(dn + 16384 + j * 1024); rx[d][j] = *(const v4u*)(dn + 24576 + j * 1024); } }
                const bf16* xr_ = X2 + (size_t)(cgi * 64 + 16 * mt + r8) * 1024 + 768 + h * 64 + c8 * 8;
#pragma unroll
                for (int j = 0; j < 2; ++j) gx[j] = *(const v4u*)(xr_ + (size_t)j * 8 * 1024);
            };
            issue(0);
#pragma unroll
            for (int it = 0; it < 3; ++it) {
                const int cgi = (vcu >> 1) + 128 * it;
                bf16* xrow = X2 + (size_t)(cgi * 64 + 16 * mt + r8) * 1024 + 768 + h * 64 + c8 * 8;
                __syncthreads();
#pragma unroll
                for (int j = 0; j < 4; ++j) *(LAS v4u*)(SST + (wave >> 1) * 9216 + (32 * (wave & 1) + 8 * j + r8) * 144 + c8 * 16) = sx[j];
#pragma unroll
                for (int d = 0; d < 2; ++d)
#pragma unroll
                    for (int j = 0; j < 2; ++j) { *(LAS v4u*)(wv + d * 2304 + (8 * j + r8) * 144 + c8 * 16) = px[d][j]; *(LAS v4u*)(wv + 4608 + d * 2304 + (8 * j + r8) * 144 + c8 * 16) = rx[d][j]; }
                const v4u g0 = gx[0], g1 = gx[1];
                if (it < 2) issue(it + 1);
                __syncthreads();
                f32x4 acc[4];
#pragma unroll
                for (int nt = 0; nt < 4; ++nt) { const v2u r0 = *(const LAS v2u*)(wv + 4608 + fr * 144 + (16 * nt + 4 * fq) * 2), r1 = *(const LAS v2u*)(wv + 4608 + 2304 + fr * 144 + (16 * nt + 4 * fq) * 2);
                    acc[nt] = (f32x4){bflo(r0.x) + bflo(r1.x), bfhi(r0.x) + bfhi(r1.x), bflo(r0.y) + bflo(r1.y), bfhi(r0.y) + bfhi(r1.y)}; }
#pragma unroll
                for (int d = 0; d < 2; ++d)
#pragma unroll
                    for (int s = 0; s < 2; ++s) { const bf16x8 pf = *(const LAS bf16x8*)(wv + d * 2304 + fr * 144 + 64 * s + 16 * fq);
#pragma unroll
                        for (int nt = 0; nt < 4; ++nt) { const bf16x8 sf = *(const LAS bf16x8*)(SST + (pr * 2 + d) * 9216 + (16 * nt + fr) * 144 + 64 * s + 16 * fq); acc[nt] = mfma16(sf, pf, acc[nt]); } }
                float ss = 0.f;
#pragma unroll
                for (int nt = 0; nt < 4; ++nt) ss += (acc[nt][0] * acc[nt][0] + acc[nt][1] * acc[nt][1]) + (acc[nt][2] * acc[nt][2] + acc[nt][3] * acc[nt][3]);
                ss += __shfl_xor(ss, 16); ss += __shfl_xor(ss, 32);
                const float rinv = rsqrtf(ss * (1.0f / 64.0f) + EPS);
#pragma unroll
                for (int nt = 0; nt < 4; ++nt) { const f32x4 on = onv[nt];
                    v2u o; o.x = pk2(acc[nt][0] * rinv * on[0], acc[nt][1] * rinv * on[1]); o.y = pk2(acc[nt][2] * rinv * on[2], acc[nt][3] * rinv * on[3]);
                    *(LAS v2u*)(wv + 9216 + fr * 144 + (16 * nt + 4 * fq) * 2) = o; }
#pragma unroll
                for (int j = 0; j < 2; ++j) { const v4u x = *(const LAS v4u*)(wv + 9216 + (8 * j + r8) * 144 + c8 * 16); const v4u gt = j == 0 ? g0 : g1; v4u o;
#pragma unroll
                    for (int e = 0; e < 4; ++e) o[e] = pk2(bflo(x[e]) * bflo(gt[e]), bfhi(x[e]) * bfhi(gt[e]));
                    *(v4u*)(xrow + (size_t)j * 8 * 1024) = dry ? gt : o; }
            }
        }
        }
#endif
        GRID_BAR();
#ifndef SKIP_PC
    asm volatile("; MARK_PC" ::: "memory");
    { PHASE_LOCALS();
        {
            unsigned char* ws = WSP; bf16* X2 = (bf16*)(ws + WS_X2); bf16* Wt_out = (bf16*)(ws + WS_WOUT); bf16* Yb = (bf16*)(ws + WS_Z); float* SS = (float*)(ws + WS_SS);
            pg8::Gemm g{X2, Wt_out + (size_t)l * 1024 * 1024, NTOK, 1024, 1024};
            pg8::EpiOut E{Yb, SS};
            const int x = bid & 7, j = bid >> 3;
            const bool isP = j >= 16;
            if (l == 0) stage_layer_tables(MISC, lds, 1, tid, vcu);
#pragma nounroll
            for (int r = 0; r < 2; ++r) {
                pg8::OneSched S; S.pm = r == 0 ? 8 * x + (j & 7) : 64 + 4 * x + (j & 3); S.pn = r == 0 ? (j >> 3) : (j >> 2);
                pg8::gemm_phase<pg8::EpiOut, pg8::OneSched, true, true>(lds, g, S, E);
                xcd_arrive(bar, 2 * l + r);
                if (r == 0 && isP) { xcd_arrive(bar, 2 * l + 1); break; }
            }
            xcd_wait(bar, 2 * l);
            const int wrk = (x * 16 + (j & 15)) * NWAVES + wave;
#pragma nounroll
            for (int s = 0; s < 2; ++s) {
                if (s == 1) { if (!isP) break; xcd_wait(bar, 2 * l + 1); }
                const int rb = s == 1 ? 16384 : (isP ? 0 : 8192);
                pd_rows<8>(MISC, l + 1, rb, rb + 8192, wrk, 128 * NWAVES, lane);
            }
            if (l == 0) ctx_rows(MISC, 1, vcu * (NWAVES * 64) + tid, G * NWAVES * 64);
        }
    }
#endif
        if (l == 1) break;
        GRID_BAR();
    }
}

extern "C" void kernel_launch(void* const* d_in, const int* in_sizes, int n_in, void* d_out, int out_size, void* d_ws, size_t ws_size, hipStream_t stream) {
    static int grid = 0;
    if (grid == 0) {
        if (n_in != 21 || ws_size < WS_END) { fprintf(stderr, "kernel_launch: unexpected n_in %d or ws %zu\n", n_in, ws_size); grid = -1; return; }
        int dev = 0, cus = 0, per_cu = 0;
        if (hipGetDevice(&dev) != hipSuccess || hipDeviceGetAttribute(&cus, hipDeviceAttributeMultiprocessorCount, dev) != hipSuccess) { grid = -1; return; }
        if (hipFuncSetAttribute((const void*)mk_fwd, hipFuncAttributeMaxDynamicSharedMemorySize, LDS_BYTES) != hipSuccess) { fprintf(stderr, "kernel_launch: hipFuncSetAttribute failed\n"); grid = -1; return; }
        if (hipOccupancyMaxActiveBlocksPerMultiprocessor(&per_cu, (const void*)mk_fwd, NWAVES * 64, LDS_BYTES) != hipSuccess || per_cu < 1) { fprintf(stderr, "kernel_launch: occupancy query says %d\n", per_cu); (void)hipGetLastError(); per_cu = 1; }
        grid = cus;
        if (grid != 256) { fprintf(stderr, "kernel_launch: the phase schedules are laid out for 256 CUs, found %d\n", cus); grid = -1; return; }
    }
    if (grid < 0) return;
    static_assert(CTL_ZERO_BYTES == 256 * 64 * 4, "the kernel zeroes 64 control words per workgroup");
    Args a{};
    for (int i = 0; i < 21; ++i) a.in[i] = (const float*)d_in[i];
    a.out = (float*)d_out; a.ws = (unsigned char*)d_ws;
    void* kargs[] = {&a};
    hipError_t e = hipLaunchCooperativeKernel((const void*)mk_fwd, dim3(grid), dim3(NWAVES * 64), kargs, LDS_BYTES, stream);
    if (e != hipSuccess) fprintf(stderr, "cooperative launch failed: %s (grid %d)\n", hipGetErrorString(e), grid);
}
```
